# Optimizing an MI355X kernel written in HIP

```python
import math
import jax, jax.numpy as jnp
from jax import lax
import numpy as np

D_MODEL = 2048
BATCH = 4
SEQ = 4096
DEPTH = 4

HEAD_DIM = 128
V_HEAD_DIM = 2 * HEAD_DIM
N_DIFF_HEADS = D_MODEL // V_HEAD_DIM
ATTN_WIDTH = N_DIFF_HEADS * V_HEAD_DIM
Q_BLOCK = 128
ROPE_THETA = 10000.0
LAMBDA_INIT_SCALE = 0.1
CHUNK = 128
N_SGU_GROUPS = 8
SGU_WIDTH = D_MODEL
SGU_GROUP_DIM = SGU_WIDTH // N_SGU_GROUPS
N_BRANCHES = 2
FFN_HIDDEN = -(-8 * D_MODEL // (3 * 256)) * 256
EPS = 1e-6

Q_W = N_DIFF_HEADS * 2 * HEAD_DIM
K_W = N_DIFF_HEADS * 2 * HEAD_DIM
V_W = ATTN_WIDTH
Z_W = 2 * SGU_WIDTH
GATE_W = N_BRANCHES * D_MODEL
IN_COLS = Q_W + K_W + V_W + Z_W + GATE_W

kernel_name = 'hybrid_diffattn_sgu_gated_block'


def rms_norm(x, g):
    x32 = x.astype(jnp.float32)
    y = x32 * lax.rsqrt(jnp.mean(x32 * x32, axis=-1, keepdims=True) + EPS)
    return (y * g.astype(jnp.float32)).astype(x.dtype)


def layer_norm(x, g, b):
    x32 = x.astype(jnp.float32)
    mu = jnp.mean(x32, axis=-1, keepdims=True)
    var = jnp.mean(jnp.square(x32 - mu), axis=-1, keepdims=True)
    y = (x32 - mu) * lax.rsqrt(var + EPS)
    return (y * g.astype(jnp.float32) + b.astype(jnp.float32)).astype(x.dtype)


def rope_tables(positions, dtype):
    inv_freq = ROPE_THETA ** (-jnp.arange(0, HEAD_DIM, 2, dtype=jnp.float32) / HEAD_DIM)
    ang = positions.astype(jnp.float32)[..., None] * inv_freq
    ang = jnp.concatenate([ang, ang], axis=-1)[:, :, None, None, :]
    return jnp.cos(ang).astype(dtype), jnp.sin(ang).astype(dtype)


def apply_rope(t, cos, sin):
    t1, t2 = jnp.split(t, 2, axis=-1)
    return t * cos + jnp.concatenate([-t2, t1], axis=-1) * sin


def diff_attention(q, k, v, lam):
    S = q.shape[1]
    scale = HEAD_DIM ** -0.5
    outs = []
    for i in range(S // Q_BLOCK):
        q0 = i * Q_BLOCK
        kv_len = q0 + Q_BLOCK
        qb = q[:, q0:kv_len]
        kb = k[:, :kv_len]
        vb = v[:, :kv_len]
        s = jnp.einsum('bqhcd,bkhcd->bhcqk', qb, kb).astype(jnp.float32) * scale
        causal = (q0 + jnp.arange(Q_BLOCK))[:, None] >= jnp.arange(kv_len)[None, :]
        s = jnp.where(causal, s, -jnp.inf)
        p = jax.nn.softmax(s, axis=-1)
        a = p[:, :, 0] - lam * p[:, :, 1]
        outs.append(jnp.einsum('bhqk,bkhe->bqhe', a.astype(vb.dtype), vb))
    return jnp.concatenate(outs, axis=1)


def chunk_spatial_gating(u, vg, ln_g, ln_b, w_s, b_s):
    B, S, _ = u.shape
    vg = layer_norm(vg, ln_g, ln_b)
    vg = vg.reshape(B, S // CHUNK, CHUNK, N_SGU_GROUPS, SGU_GROUP_DIM)
    w = w_s * jnp.tril(jnp.ones((CHUNK, CHUNK), dtype=w_s.dtype))
    mixed = jnp.einsum('gij,bnjgc->bnigc', w, vg) + b_s.T[:, :, None]
    return u * mixed.reshape(B, S, SGU_WIDTH)


def setup_inputs(seed: int = 0) -> dict:
    key = jax.random.key(seed)
    ks = jax.random.split(key, 18)
    f32 = jnp.float32
    x = jax.random.normal(ks[0], (BATCH, SEQ, D_MODEL), f32)
    offsets = jax.random.randint(ks[1], (BATCH, 1), 0, 1024, dtype=jnp.int32)
    positions = offsets + jnp.arange(SEQ, dtype=jnp.int32)[None, :]
    norm_attn = 1.0 + 0.1 * jax.random.normal(ks[2], (DEPTH, D_MODEL), f32)
    w_in = jax.random.normal(ks[3], (DEPTH, D_MODEL, IN_COLS), f32) * D_MODEL ** -0.5
    gate_b = 0.1 * jax.random.normal(ks[4], (DEPTH, GATE_W), f32)
    lam = LAMBDA_INIT_SCALE * jax.random.normal(ks[5], (DEPTH, 4, HEAD_DIM), f32)
    subln = 1.0 + 0.1 * jax.random.normal(ks[6], (DEPTH, V_HEAD_DIM), f32)
    sgu_ln_g = 1.0 + 0.1 * jax.random.normal(ks[7], (DEPTH, SGU_WIDTH), f32)
    sgu_ln_b = 0.02 * jax.random.normal(ks[8], (DEPTH, SGU_WIDTH), f32)
    w_spatial = jax.random.normal(ks[9], (DEPTH, N_SGU_GROUPS, CHUNK, CHUNK), f32) * CHUNK ** -0.5
    b_spatial = 1.0 + 0.1 * jax.random.normal(ks[10], (DEPTH, N_SGU_GROUPS, CHUNK), f32)
    w_branch = jax.random.normal(ks[11], (DEPTH, N_BRANCHES, ATTN_WIDTH, D_MODEL), f32) * ATTN_WIDTH ** -0.5
    w_out = jax.random.normal(ks[12], (DEPTH, D_MODEL, D_MODEL), f32) * D_MODEL ** -0.5
    norm_ffn = 1.0 + 0.1 * jax.random.normal(ks[13], (DEPTH, D_MODEL), f32)
    w_ffn_in = jax.random.normal(ks[14], (DEPTH, D_MODEL, 2 * FFN_HIDDEN), f32) * D_MODEL ** -0.5
    w_ffn_out = jax.random.normal(ks[15], (DEPTH, FFN_HIDDEN, D_MODEL), f32) * FFN_HIDDEN ** -0.5
    norm_final = 1.0 + 0.1 * jax.random.normal(ks[16], (D_MODEL,), f32)
    return {'x': x, 'positions': positions, 'norm_attn': norm_attn, 'w_in': w_in,
            'gate_b': gate_b, 'lam': lam, 'subln': subln, 'sgu_ln_g': sgu_ln_g,
            'sgu_ln_b': sgu_ln_b, 'w_spatial': w_spatial, 'b_spatial': b_spatial,
            'w_branch': w_branch, 'w_out': w_out, 'norm_ffn': norm_ffn,
            'w_ffn_in': w_ffn_in, 'w_ffn_out': w_ffn_out, 'norm_final': norm_final}


def reference(x, positions, norm_attn, w_in, gate_b, lam, subln, sgu_ln_g, sgu_ln_b,
              w_spatial, b_spatial, w_branch, w_out, norm_ffn, w_ffn_in, w_ffn_out,
              norm_final):
    B, S, _ = x.shape
    cos, sin = rope_tables(positions, x.dtype)
    splits = [Q_W, Q_W + K_W, Q_W + K_W + V_W, Q_W + K_W + V_W + Z_W]
    for l in range(DEPTH):
        h = rms_norm(x, norm_attn[l])
        proj = h @ w_in[l]
        q, k, v, z, gate_logits = jnp.split(proj, splits, axis=-1)

        q = apply_rope(q.reshape(B, S, N_DIFF_HEADS, 2, HEAD_DIM), cos, sin)
        k = apply_rope(k.reshape(B, S, N_DIFF_HEADS, 2, HEAD_DIM), cos, sin)
        v = v.reshape(B, S, N_DIFF_HEADS, V_HEAD_DIM)
        lam_init = 0.8 - 0.6 * math.exp(-0.3 * l)
        lp = lam[l].astype(jnp.float32)
        lam_full = jnp.exp(jnp.sum(lp[0] * lp[1])) - jnp.exp(jnp.sum(lp[2] * lp[3])) + lam_init
        o = diff_attention(q, k, v, lam_full)
        o = rms_norm(o, subln[l]) * (1.0 - lam_init)
        y_attn = o.reshape(B, S, ATTN_WIDTH) @ w_branch[l, 0]

        u, vg = jnp.split(jax.nn.gelu(z, approximate=False), 2, axis=-1)
        sg = chunk_spatial_gating(u, vg, sgu_ln_g[l], sgu_ln_b[l], w_spatial[l], b_spatial[l])
        y_sgu = sg @ w_branch[l, 1]

        g_attn, g_sgu = jnp.split(jax.nn.sigmoid(gate_logits + gate_b[l]), 2, axis=-1)
        x = x + (g_attn * y_attn + g_sgu * y_sgu) @ w_out[l]

        h = rms_norm(x, norm_ffn[l])
        a, b = jnp.split(h @ w_ffn_in[l], 2, axis=-1)
        x = x + (jax.nn.silu(a) * b) @ w_ffn_out[l]
    return rms_norm(x, norm_final)
```

```cpp
#include <hip/hip_runtime.h>
#include <hip/hip_bf16.h>
#include <cstdio>
#include <cstdint>

#ifndef MK_MULTI
#define MK_MULTI 0
#endif

#ifndef DBG_CUT
#define DBG_CUT 0
#endif
#ifndef REP_P6_SKIPEPI
#define REP_P6_SKIPEPI 0
#endif
#ifndef ATT_ROT
#define ATT_ROT 1
#endif
#ifndef ATT_PROBE
#define ATT_PROBE 0
#endif
#ifndef LOOSE_RESTART
#define LOOSE_RESTART 1
#endif
#ifndef REP_P0
#define REP_P0 1
#endif
#ifndef REP_ATT
#define REP_ATT 1
#endif
#ifndef REP_P1
#define REP_P1 1
#endif
#ifndef REP_P3
#define REP_P3 1
#endif
#ifndef REP_P4
#define REP_P4 1
#endif
#ifndef REP_P6
#define REP_P6 1
#endif
#ifndef REP_SGU
#define REP_SGU 1
#endif
#ifndef DBG_ROT
#define DBG_ROT 0
#endif
#ifndef DBG_SRC
#define DBG_SRC 0
#endif
#ifndef EN_P0
#define EN_P0 1
#endif
#ifndef EN_P1
#define EN_P1 1
#endif
#ifndef EN_ATT
#define EN_ATT 1
#endif
#ifndef EN_SGU
#define EN_SGU 1
#endif
#ifndef EN_P3
#define EN_P3 1
#endif
#ifndef EN_P4
#define EN_P4 1
#endif
#ifndef EN_P5
#define EN_P5 1
#endif
#ifndef EN_P6
#define EN_P6 1
#endif
#ifndef EN_P7
#define EN_P7 1
#endif
#define LAS __attribute__((address_space(3)))
#define GAS __attribute__((address_space(1)))
typedef unsigned short bf16_t;
typedef short bf16x8 __attribute__((ext_vector_type(8)));
typedef short s16x4 __attribute__((ext_vector_type(4)));
typedef float f32x2 __attribute__((ext_vector_type(2)));
typedef float f32x4 __attribute__((ext_vector_type(4)));
typedef float f32x16 __attribute__((ext_vector_type(16)));
typedef unsigned u32x2 __attribute__((ext_vector_type(2)));
typedef unsigned u32x4 __attribute__((ext_vector_type(4)));

constexpr int DM = 2048, NBATCH = 4, SEQ = 4096, DEPTH = 4, MTOK = NBATCH * SEQ;
constexpr int NHEAD = 8, HDIM = 128, INCOLS = 14336, FFH = 5632, KBR = 4096;
constexpr float EPS = 1e-6f;

constexpr size_t WS_CTL = 0, CTL_ZERO_BYTES = 32768;
constexpr size_t SZ_WIN = (size_t)INCOLS * DM * 2, SZ_WBR = (size_t)DM * KBR * 2, SZ_WOUT = (size_t)DM * DM * 2, SZ_WFI = (size_t)2 * FFH * DM * 2, SZ_WFO = (size_t)DM * FFH * 2;
constexpr size_t WS_WIN = 1u << 20;
constexpr size_t WS_WBR = WS_WIN + DEPTH * SZ_WIN;
constexpr size_t WS_WOUT = WS_WBR + DEPTH * SZ_WBR;
constexpr size_t WS_WFI = WS_WOUT + DEPTH * SZ_WOUT;
constexpr size_t WS_WFO = WS_WFI + DEPTH * SZ_WFI;
constexpr size_t WS_WST = WS_WFO + DEPTH * SZ_WFO;
constexpr size_t WS_COS = WS_WST + (size_t)DEPTH * 8 * 128 * 128 * 2;
constexpr size_t WS_SIN = WS_COS + (size_t)MTOK * 64 * 2;
constexpr size_t WS_X = WS_SIN + (size_t)MTOK * 64 * 2;
constexpr size_t WS_XB = WS_X + (size_t)MTOK * DM * 4;
constexpr size_t WS_SSQ = WS_XB + (size_t)MTOK * DM * 2;
constexpr size_t WS_LNST = WS_SSQ + (size_t)MTOK * 8 * 4;
constexpr size_t WS_QH = WS_LNST + (size_t)MTOK * 16 * 4;
constexpr size_t WS_KH = WS_QH + (size_t)MTOK * DM * 2;
constexpr size_t WS_VH = WS_KH + (size_t)MTOK * DM * 2;
constexpr size_t WS_HID = WS_QH;
constexpr size_t WS_U = WS_VH + (size_t)MTOK * DM * 2;
constexpr size_t WS_MRG = WS_U;
constexpr size_t WS_GV = WS_U + (size_t)MTOK * DM * 2;
constexpr size_t WS_GA = WS_GV + (size_t)MTOK * DM * 2;
constexpr size_t WS_GS = WS_GA + (size_t)MTOK * DM * 2;
constexpr size_t WS_OH = WS_GS + (size_t)MTOK * DM * 2;
constexpr size_t WS_A2 = WS_OH + (size_t)MTOK * DM * 2 * 4;
constexpr size_t WS_END = WS_A2 + (size_t)MTOK * KBR * 2;
static_assert((size_t)MTOK * FFH * 2 <= 3 * (size_t)MTOK * DM * 2, "hidden overlays q|k|v");
constexpr int CW_BAR = 4096;

constexpr int RING_BYTES = 131072;
constexpr int XS_OFF = RING_BYTES;
constexpr int RS_OFF = XS_OFF + 8192;
constexpr int MISC_OFF = RS_OFF + 1024;
constexpr int LDS_BYTES = 147456;

typedef __bf16 bf16x2_t __attribute__((ext_vector_type(2)));
__device__ __forceinline__ unsigned cvt_pk_bf16(float lo, float hi) { f32x2 v = {lo, hi}; bf16x2_t b = __builtin_convertvector(v, bf16x2_t); return __builtin_bit_cast(unsigned, b); }
__device__ __forceinline__ float bf_lo(unsigned w) { return __uint_as_float(w << 16); }
__device__ __forceinline__ float bf_hi(unsigned w) { return __uint_as_float(w & 0xffff0000u); }
__device__ __forceinline__ int lane_id() { int r; asm volatile("v_mbcnt_lo_u32_b32 %0, -1, 0\n\tv_mbcnt_hi_u32_b32 %0, -1, %0" : "=v"(r)); return r; }
#define TID_OF(wv) (((wv) << 6) | lane_id())
__device__ __forceinline__ float wave_sum(float v, int lane) {
#pragma unroll
    for (int o = 1; o < 64; o <<= 1) v += __uint_as_float((unsigned)__builtin_amdgcn_ds_bpermute((lane ^ o) << 2, (int)__float_as_uint(v)));
    return v;
}
__device__ __forceinline__ float sum_x16_x32(float v) {
    { auto r = __builtin_amdgcn_permlane16_swap(__float_as_uint(v), __float_as_uint(v), false, false); v = __uint_as_float(r[0]) + __uint_as_float(r[1]); }
    { auto r = __builtin_amdgcn_permlane32_swap(__float_as_uint(v), __float_as_uint(v), false, false); v = __uint_as_float(r[0]) + __uint_as_float(r[1]); }
    return v;
}
__device__ __forceinline__ float sigmoidf_(float x) { return __builtin_amdgcn_rcpf(1.0f + __builtin_amdgcn_exp2f(-1.4426950408889634f * x)); }
__device__ __forceinline__ f32x2 gelu_pk(f32x2 v) {
    const f32x2 av = __builtin_elementwise_abs(v), d = av * 0.2316418882f + 1.0f;
    f32x2 t; t.x = __builtin_amdgcn_rcpf(d.x); t.y = __builtin_amdgcn_rcpf(d.y);
    f32x2 q = t * 0.5307027145f + (-0.7265760135f); q = q * t + 0.7107068705f; q = q * t + (-0.142248368f); q = q * t + 0.127414796f; q = q * t;
    const f32x2 s = (v * v) * (-0.72134752044f);
    f32x2 e; e.x = __builtin_amdgcn_exp2f(s.x); e.y = __builtin_amdgcn_exp2f(s.y);
    const f32x2 m = v * (q * e), r = v - m;
    f32x2 o; o.x = v.x < 0.f ? m.x : r.x; o.y = v.y < 0.f ? m.y : r.y; return o;
}
__device__ __forceinline__ f32x4 gelu4(f32x4 v) { const f32x2 a = gelu_pk((f32x2){v[0], v[1]}), b = gelu_pk((f32x2){v[2], v[3]}); return (f32x4){a.x, a.y, b.x, b.y}; }
__device__ __forceinline__ void gelu8(f32x4 (&g)[2], f32x2& s1, f32x2& s2) {
    f32x2 v[4], t[4], q[4], e[4];
#pragma unroll
    for (int i = 0; i < 4; ++i) v[i] = (f32x2){g[i >> 1][(i & 1) * 2], g[i >> 1][(i & 1) * 2 + 1]};
#pragma unroll
    for (int i = 0; i < 4; ++i) { const f32x2 d = __builtin_elementwise_abs(v[i]) * 0.2316418882f + 1.0f; t[i].x = __builtin_amdgcn_rcpf(d.x); t[i].y = __builtin_amdgcn_rcpf(d.y); }
    __builtin_amdgcn_sched_barrier(0);
#pragma unroll
    for (int i = 0; i < 4; ++i) { const f32x2 s = (v[i] * v[i]) * (-0.72134752044f); e[i].x = __builtin_amdgcn_exp2f(s.x); e[i].y = __builtin_amdgcn_exp2f(s.y); }
    __builtin_amdgcn_sched_barrier(0);
#pragma unroll
    for (int i = 0; i < 4; ++i) q[i] = t[i] * 0.5307027145f + (-0.7265760135f);
    __builtin_amdgcn_sched_barrier(0);
#pragma unroll
    for (int i = 0; i < 4; ++i) q[i] = q[i] * t[i] + 0.7107068705f;
    __builtin_amdgcn_sched_barrier(0);
#pragma unroll
    for (int i = 0; i < 4; ++i) q[i] = q[i] * t[i] + (-0.142248368f);
    __builtin_amdgcn_sched_barrier(0);
#pragma unroll
    for (int i = 0; i < 4; ++i) q[i] = q[i] * t[i] + 0.127414796f;
    __builtin_amdgcn_sched_barrier(0);
#pragma unroll
    for (int i = 0; i < 4; ++i) q[i] = (q[i] * t[i]) * e[i];
    __builtin_amdgcn_sched_barrier(0);
#pragma unroll
    for (int i = 0; i < 4; ++i) { f32x2 mx; mx.x = fmaxf(v[i].x, 0.f); mx.y = fmaxf(v[i].y, 0.f); const f32x2 o = mx - __builtin_elementwise_abs(v[i]) * q[i];
        s1 += o; s2 += o * o; g[i >> 1][(i & 1) * 2] = o.x; g[i >> 1][(i & 1) * 2 + 1] = o.y; }
}
__device__ __forceinline__ u32x4 pack8(f32x4 a, f32x4 b) { u32x4 w; w.x = cvt_pk_bf16(a[0], a[1]); w.y = cvt_pk_bf16(a[2], a[3]); w.z = cvt_pk_bf16(b[0], b[1]); w.w = cvt_pk_bf16(b[2], b[3]); return w; }

namespace pg8 {
constexpr int BM = 256, BK = 64, HALF = 128, HTB = HALF * BK * 2, STAGE_BYTES = 8 * HTB, NXCD = 8, WGM = 8;
__host__ __device__ __forceinline__ int lds_byte(int r, int c) { const int st = (r >> 4) * 2 + (c >> 5), rr = r & 15, cc = c & 31, ob = rr * 64 + cc * 2; return st * 1024 + (ob ^ (((ob >> 9) & 1) << 5)); }
__host__ __device__ __forceinline__ void stage_rc(int b, int& R, int& C) { const int st = b / 1024, sb = b % 1024, swz = sb ^ (((sb >> 9) & 1) << 5); R = (st >> 1) * 16 + swz / 64; C = (st & 1) * 32 + (swz % 64) / 2; }
__host__ __device__ __forceinline__ int perm32(int rho) { const int n = rho >> 4, i = rho & 15; return 8 * (i >> 2) + 4 * n + (i & 3); }
struct Unit { int pm, pn; };
struct Gemm { const bf16_t* A; const bf16_t* Bt; int M, N, K; };
struct StaticOrder {
    int nM, nN, nwg, G, c, rot;
    __host__ __device__ void init(int M, int N, int G_, int c_, int rot_ = 0) { nM = M / BM; nN = N / BM; nwg = nM * nN; G = G_; c = c_; rot = rot_; }
    __host__ __device__ bool next(int i, Unit& u) const {
        if (G == 256 && nM == 64 && rot == 0 && (nN & 3) == 0) { const int pn = 4 * i + (c >> 6); if (pn >= nN) return false; u.pm = 8 * (c & 7) + ((c >> 3) & 7); u.pn = pn; return true; }
        const long L = (long)i * G + c; if (L >= nwg) return false;
        int wgid = (int)L; { const int q = nwg / NXCD, r = nwg % NXCD, xcd = wgid % NXCD, off = wgid / NXCD; wgid = (xcd < r ? xcd * (q + 1) : r * (q + 1) + (xcd - r) * q) + off; }
        const int nig = WGM * nN, gid = wgid / nig, fm = gid * WGM, gsz = (nM - fm) < WGM ? (nM - fm) : WGM;
        u.pm = fm + ((wgid % nig) % gsz); u.pn = ((wgid % nig) / gsz + rot) % nN; return true;
    }
};
template <class Epi>
__device__ __forceinline__ void gemm_phase(LAS unsigned char* lds, const Gemm g, const StaticOrder& S, const Epi& E, const int wv) {
    int tid_ = TID_OF(wv); asm volatile("" : "+v"(tid_));
    const int tid = tid_, wid = __builtin_amdgcn_readfirstlane(tid >> 6), lane = tid & 63, wr = wid >> 2, wc = wid & 3, fr = lane & 15, fq = lane >> 4;
    const int K = g.K, nt = K / BK;
    unsigned voffA[2], voffB[2];
#pragma unroll
    for (int i = 0; i < 2; ++i) { int R, C; stage_rc(tid * 16 + i * 8192, R, C); const int Rb = (R & ~31) + perm32(R & 31);
        voffA[i] = (unsigned)(R * K + C) * 2u; voffB[i] = (unsigned)(Rb * K + C) * 2u; }
    const size_t kstep = (size_t)(BK * 2);
    const size_t hstep = (size_t)HALF * K * 2;
    const size_t tstep = 2 * hstep;
    const unsigned ldsw = (unsigned)wid * 1024u;
    const int aoff = lds_byte(wr * 64 + fr, fq * 8), boff = lds_byte(wc * 32 + fr, fq * 8);
#define PG8_SA(b, h) (((b) * 2 + (h)) * HTB)
#define PG8_SB(b, h) ((4 + (b) * 2 + (h)) * HTB)
#define PG8_STAGE(bufoff, gbase, voff) do { _Pragma("unroll") for (int _i = 0; _i < 2; ++_i) { unsigned _vo = (voff)[_i]; asm volatile("" : "+v"(_vo)); \
        __builtin_amdgcn_global_load_lds((const unsigned*)((const char*)(gbase) + _vo), (LAS unsigned*)(lds + (bufoff) + ldsw + _i * 8192), 16, 0, 0); } } while (0)
#define PG8_LDA(dst, b, h) do { _Pragma("unroll") for (int m = 0; m < 4; ++m) _Pragma("unroll") for (int k = 0; k < 2; ++k) dst[m][k] = *(const LAS bf16x8*)(lds + PG8_SA(b, h) + aoff + m * 2048 + k * 1024); } while (0)
#define PG8_LDB(dst, b, h) do { _Pragma("unroll") for (int n = 0; n < 2; ++n) _Pragma("unroll") for (int k = 0; k < 2; ++k) dst[n][k] = *(const LAS bf16x8*)(lds + PG8_SB(b, h) + boff + n * 2048 + k * 1024); } while (0)
#define PG8_MMA(ai, bj, At, Bt) do { __builtin_amdgcn_s_setprio(1); _Pragma("unroll") for (int m = 0; m < 4; ++m) _Pragma("unroll") for (int n = 0; n < 2; ++n) _Pragma("unroll") for (int k = 0; k < 2; ++k) \
        acc[ai][bj][m][n] = __builtin_amdgcn_mfma_f32_16x16x32_bf16(Bt[n][k], At[m][k], acc[ai][bj][m][n], 0, 0, 0); __builtin_amdgcn_s_setprio(0); } while (0)
#define PG8_MMA0(ai, bj, At, Bt) do { __builtin_amdgcn_s_setprio(1); _Pragma("unroll") for (int m = 0; m < 4; ++m) _Pragma("unroll") for (int n = 0; n < 2; ++n) { \
        acc[ai][bj][m][n] = __builtin_amdgcn_mfma_f32_16x16x32_bf16(Bt[n][0], At[m][0], (f32x4){0.f, 0.f, 0.f, 0.f}, 0, 0, 0); \
        acc[ai][bj][m][n] = __builtin_amdgcn_mfma_f32_16x16x32_bf16(Bt[n][1], At[m][1], acc[ai][bj][m][n], 0, 0, 0); } __builtin_amdgcn_s_setprio(0); } while (0)
#define PG8_WAIT_V(n) asm volatile("s_waitcnt vmcnt(" #n ")" ::: "memory")
#define PG8_WAIT_L(n) asm volatile("s_waitcnt lgkmcnt(" #n ")" ::: "memory")
#define PG8_BAR __builtin_amdgcn_s_barrier()
#define PG8_SCHED __builtin_amdgcn_sched_barrier(0)
    Unit cur, nxt; int ui = 0;
    if (!S.next(0, cur)) return;
    f32x4 acc[2][2][4][2];
    bf16x8 At[4][2], B0[2][2], B1[2][2];
    const char* cA = (const char*)g.A + (size_t)cur.pm * tstep; const char* cB = (const char*)g.Bt + (size_t)cur.pn * tstep;
    PG8_STAGE(PG8_SB(0, 0), cB, voffB); PG8_STAGE(PG8_SB(0, 1), cB + hstep, voffB); PG8_STAGE(PG8_SA(0, 0), cA, voffA); PG8_STAGE(PG8_SA(0, 1), cA + hstep, voffA);
    if (wr == 1) PG8_BAR;
    PG8_WAIT_V(2); PG8_BAR;
    PG8_STAGE(PG8_SB(1, 0), cB + kstep, voffB); PG8_STAGE(PG8_SA(1, 0), cA + kstep, voffA); PG8_STAGE(PG8_SB(1, 1), cB + hstep + kstep, voffB);
    PG8_WAIT_V(6); PG8_BAR;
    for (;;) {
        const bool has_next = S.next(ui + 1, nxt);
        const char* nA = has_next ? (const char*)g.A + (size_t)nxt.pm * tstep : cA; const char* nB = has_next ? (const char*)g.Bt + (size_t)nxt.pn * tstep : cB;
#define K_BODY(t, MMAF, MIDCHK, W12) do { \
            if constexpr (Epi::MID && MIDCHK) { if ((t) == (nt >> 1)) E.mid(acc, cur, wr, wc, fr, fq); } \
            const bool last = ((t) == nt - 2); \
            const char* a1 = cA + (size_t)((t) + 1) * kstep; \
            const char* a2 = last ? nA : cA + (size_t)((t) + 2) * kstep; const char* b2 = last ? nB : cB + (size_t)((t) + 2) * kstep; \
            const char* a3 = a2 + kstep; const char* b3 = b2 + kstep; \
            PG8_LDB(B0, 0, 0); PG8_LDB(B1, 0, 1); PG8_SCHED; PG8_LDA(At, 0, 0); PG8_STAGE(PG8_SA(1, 1), a1 + hstep, voffA); \
            W12; PG8_WAIT_L(0); PG8_BAR; MMAF(0, 0, At, B0); MMAF(0, 1, At, B1); PG8_BAR; PG8_SCHED; \
            PG8_LDA(At, 0, 1); PG8_STAGE(PG8_SB(0, 0), b2, voffB); PG8_STAGE(PG8_SB(0, 1), b2 + hstep, voffB); PG8_STAGE(PG8_SA(0, 0), a2, voffA); \
            W12; PG8_WAIT_L(0); PG8_BAR; MMAF(1, 0, At, B0); MMAF(1, 1, At, B1); PG8_BAR; PG8_SCHED; \
            PG8_LDB(B0, 1, 0); PG8_LDB(B1, 1, 1); PG8_SCHED; PG8_LDA(At, 1, 0); PG8_STAGE(PG8_SA(0, 1), a2 + hstep, voffA); \
            PG8_WAIT_V(8); PG8_WAIT_L(0); PG8_BAR; PG8_MMA(0, 0, At, B0); PG8_MMA(0, 1, At, B1); PG8_BAR; PG8_SCHED; \
            PG8_LDA(At, 1, 1); PG8_STAGE(PG8_SB(1, 0), b3, voffB); PG8_STAGE(PG8_SB(1, 1), b3 + hstep, voffB); PG8_STAGE(PG8_SA(1, 0), a3, voffA); \
            PG8_WAIT_V(8); PG8_WAIT_L(0); PG8_BAR; PG8_MMA(1, 0, At, B0); PG8_MMA(1, 1, At, B1); PG8_BAR; PG8_SCHED; \
        } while (0)
#define PG8_WAIT_FIRST() do { if (LOOSE_RESTART && ui > 0) { if constexpr (Epi::NVM >= 32) asm volatile("s_waitcnt vmcnt(40)" ::: "memory"); else if constexpr (Epi::NVM >= 16) asm volatile("s_waitcnt vmcnt(24)" ::: "memory"); \
            else if constexpr (Epi::NVM >= 8) asm volatile("s_waitcnt vmcnt(16)" ::: "memory"); else asm volatile("s_waitcnt vmcnt(8)" ::: "memory"); } else asm volatile("s_waitcnt vmcnt(8)" ::: "memory"); } while (0)
        K_BODY(0, PG8_MMA0, false, PG8_WAIT_FIRST());
        for (int t = 2; t < nt; t += 2) K_BODY(t, PG8_MMA, true, PG8_WAIT_V(8));
#undef PG8_WAIT_FIRST
#undef K_BODY
        if (wr == 0) PG8_BAR;
        { const int lane_ = lane_id();
          E(acc, cur, wr, wc, lane_ & 15, lane_ >> 4); }
        if (!has_next) break;
        cur = nxt; cA = nA; cB = nB; ++ui;
        if (wr == 1) PG8_BAR;
    }
    PG8_WAIT_V(0);
    PG8_BAR;
#undef PG8_SA
#undef PG8_SB
#undef PG8_STAGE
#undef PG8_LDA
#undef PG8_LDB
#undef PG8_MMA
#undef PG8_WAIT_V
#undef PG8_WAIT_L
#undef PG8_BAR
#undef PG8_SCHED
}
}

struct Args {
    const float* x; const int* pos; const float* norm_attn; const float* w_in; const float* gate_b; const float* lam; const float* subln; const float* sgu_ln_g; const float* sgu_ln_b;
    const float* w_spatial; const float* b_spatial; const float* w_branch; const float* w_out; const float* norm_ffn; const float* w_ffn_in; const float* w_ffn_out; const float* norm_final;
    float* out; unsigned char* ws; int ph_lo, ph_hi;
};

typedef const __attribute__((address_space(4))) Args* ArgP;
__device__ __forceinline__ ArgP get_args() { ArgP p = (ArgP)__builtin_amdgcn_kernarg_segment_ptr(); asm volatile("" : "+s"(p)); return p; }
template <class T> __device__ __forceinline__ T* as_global(T* p) { return (T*)(GAS T*)p; }
__device__ __forceinline__ unsigned char* launder(unsigned char* p) { asm volatile("" : "+s"(p)); return as_global(p); }
extern __shared__ __attribute__((aligned(16))) unsigned char lds_raw[];
__device__ __forceinline__ LAS unsigned char* lds_base() { return (LAS unsigned char*)lds_raw; }

typedef f32x4 AccT[2][2][4][2];
#define EPI_BAR() do { asm volatile("s_waitcnt lgkmcnt(0)" ::: "memory"); __builtin_amdgcn_s_barrier(); asm volatile("" ::: "memory"); } while (0)
typedef _Float16 h16x2 __attribute__((ext_vector_type(2)));
__device__ __forceinline__ float row_rstd(const float* ssq, int row) {
    const f32x4 a = *(const f32x4*)(ssq + (size_t)row * 8), b = *(const f32x4*)(ssq + (size_t)row * 8 + 4);
    const float s = ((a[0] + a[1]) + (a[2] + a[3])) + ((b[0] + b[1]) + (b[2] + b[3]));
    return __builtin_amdgcn_rsqf(s * (1.0f / DM) + EPS);
}
__device__ __forceinline__ void panel_rstd_to_lds(const float* ssq, int pm, int tid) { if (tid < 256) ((LAS float*)(lds_base() + RS_OFF))[tid] = row_rstd(ssq, pm * 256 + tid); }
__device__ __forceinline__ void load_rstd(float (&rs)[8], const float* ssq, int pm, int pm0, int rl0) {
    const LAS float* rsl = (const LAS float*)(lds_base() + RS_OFF);
#pragma unroll
    for (int i = 0; i < 8; ++i) { const int rl = rl0 + (i >> 2) * 128 + (i & 3) * 16; rs[i] = (pm == pm0) ? rsl[rl] : row_rstd(ssq, pm * 256 + rl); }
}

struct EpiIn {
    static constexpr bool MID = false; static constexpr int NVM = 16;
    int l, pm0;
    __device__ __forceinline__ void operator()(const AccT& acc, const pg8::Unit& u, int wr, int wc, int fr, int fq) const {
        unsigned char* ws = get_args()->ws;
        const int pn = u.pn, rl0 = wr * 64 + fr, rowu = u.pm * 256 + wr * 64;
        float rs[8]; load_rstd(rs, (const float*)(ws + WS_SSQ), u.pm, pm0, rl0);
        if (pn < 16) {
            bf16_t* dst = (bf16_t*)(ws + (pn < 8 ? WS_QH : WS_KH)); const int h = pn & 7, c = wc >> 1; const unsigned d0 = 32 * (wc & 1) + 8 * fq;
            const _Float16* cosT = (const _Float16*)(ws + WS_COS) + (size_t)rowu * 64; const _Float16* sinT = (const _Float16*)(ws + WS_SIN) + (size_t)rowu * 64;
            const unsigned lt = (unsigned)fr * 64u + d0;
            const int bb = rowu >> 12, su = rowu & 4095;
            bf16_t* dsth = dst + ((size_t)(((bb * NHEAD + h) * 2 + c) * SEQ + su)) * HDIM; const unsigned lo = (unsigned)fr * HDIM + d0;
#pragma unroll
            for (int ai = 0; ai < 2; ++ai) {
                u32x4 cw[4], sw[4];
#pragma unroll
                for (int m = 0; m < 4; ++m) { const int ro = (ai * 128 + m * 16) * 64; cw[m] = *(const u32x4*)(cosT + ro + lt); sw[m] = *(const u32x4*)(sinT + ro + lt); }
#pragma unroll
                for (int m = 0; m < 4; ++m) {
                    const float r = rs[ai * 4 + m];
                    f32x4 c0, c1, s0, s1;
#pragma unroll
                    for (int q = 0; q < 2; ++q) { const unsigned wca = cw[m][q], wcb = cw[m][q + 2], wsa = sw[m][q], wsb = sw[m][q + 2];
                        const h16x2 ca = __builtin_bit_cast(h16x2, wca), cb = __builtin_bit_cast(h16x2, wcb), sa = __builtin_bit_cast(h16x2, wsa), sb = __builtin_bit_cast(h16x2, wsb);
                        c0[2 * q] = (float)ca[0]; c0[2 * q + 1] = (float)ca[1]; c1[2 * q] = (float)cb[0]; c1[2 * q + 1] = (float)cb[1];
                        s0[2 * q] = (float)sa[0]; s0[2 * q + 1] = (float)sa[1]; s1[2 * q] = (float)sb[0]; s1[2 * q + 1] = (float)sb[1]; }
                    const f32x4 l0 = acc[ai][0][m][0] * r, l1 = acc[ai][0][m][1] * r, h0 = acc[ai][1][m][0] * r, h1 = acc[ai][1][m][1] * r;
                    const f32x4 ol0 = l0 * c0 - h0 * s0, ol1 = l1 * c1 - h1 * s1, oh0 = h0 * c0 + l0 * s0, oh1 = h1 * c1 + l1 * s1;
                    bf16_t* p = dsth + (ai * 128 + m * 16) * HDIM;
                    *(u32x4*)(p + lo) = pack8(ol0, ol1); *(u32x4*)(p + 64 + lo) = pack8(oh0, oh1);
                } }
        } else if (pn < 24) {
            const int h = pn - 16, bb = rowu >> 12, su = rowu & 4095; const unsigned lo = (unsigned)fr * HDIM + 32 * wc + 8 * fq;
#pragma unroll
            for (int bj = 0; bj < 2; ++bj) { bf16_t* vb = (bf16_t*)(ws + WS_VH) + ((size_t)(((bb * NHEAD + h) * 2 + bj) * SEQ + su)) * HDIM;
#pragma unroll
                for (int ai = 0; ai < 2; ++ai)
#pragma unroll
                    for (int m = 0; m < 4; ++m) { const float r = rs[ai * 4 + m]; *(u32x4*)(vb + (ai * 128 + m * 16) * HDIM + lo) = pack8(acc[ai][bj][m][0] * r, acc[ai][bj][m][1] * r); } }
        } else if (pn < 32) {
            bf16_t* dst = (bf16_t*)(ws + WS_U) + (size_t)rowu * DM + 256 * (pn - 24); const unsigned lo = (unsigned)fr * DM + 32 * wc + 8 * fq;
#pragma unroll
            for (int ai = 0; ai < 2; ++ai)
#pragma unroll
                for (int m = 0; m < 4; ++m) { const float r = rs[ai * 4 + m];
#pragma unroll
                    for (int bj = 0; bj < 2; ++bj) *(u32x4*)(dst + (ai * 128 + m * 16) * DM + bj * 128 + lo) = pack8(acc[ai][bj][m][0] * r, acc[ai][bj][m][1] * r); }
        } else if (pn < 40) {
            bf16_t* dst = (bf16_t*)(ws + WS_GV) + (size_t)rowu * DM + 256 * (pn - 32); const unsigned lo = (unsigned)fr * DM + 32 * wc + 8 * fq;
            LAS f32x2* xs = (LAS f32x2*)(lds_base() + XS_OFF);
#pragma unroll
            for (int ai = 0; ai < 2; ++ai)
#pragma unroll
                for (int m = 0; m < 4; ++m) {
                    const float r = rs[ai * 4 + m];
                    f32x2 a1 = {0.f, 0.f}, a2 = {0.f, 0.f};
#pragma unroll
                    for (int bj = 0; bj < 2; ++bj) { f32x4 g[2] = {acc[ai][bj][m][0] * r, acc[ai][bj][m][1] * r};
                        gelu8(g, a1, a2);
                        *(u32x4*)(dst + (ai * 128 + m * 16) * DM + bj * 128 + lo) = pack8(g[0], g[1]); }
                    const float s1 = sum_x16_x32(a1.x + a1.y), s2 = sum_x16_x32(a2.x + a2.y);
                    if (fq == 0) xs[(rl0 + ai * 128 + m * 16) * 4 + wc] = (f32x2){s1, s2};
                }
            EPI_BAR();
            { float* lnst = (float*)(ws + WS_LNST);
                const int t = 64 * (4 * wr + wc) + lane_id();
                if (t < 256) { const f32x2 a = xs[t * 4 + 0], b = xs[t * 4 + 1], c = xs[t * 4 + 2], d = xs[t * 4 + 3];
                    *(f32x2*)(lnst + (size_t)(u.pm * 256 + t) * 16 + 2 * (pn - 32)) = (f32x2){(a.x + b.x) + (c.x + d.x), (a.y + b.y) + (c.y + d.y)}; } }
            EPI_BAR();
        } else {
            const int ch0 = 128 * (pn - 40); bf16_t* dR = (bf16_t*)(ws + WS_GA) + (size_t)rowu * DM + ch0; bf16_t* dS = (bf16_t*)(ws + WS_GS) + (size_t)rowu * DM + ch0; const unsigned lo = (unsigned)fr * DM + 32 * wc + 8 * fq;
            const float* gb = get_args()->gate_b + l * 2 * DM + ch0; const unsigned lc = 32 * wc + 8 * fq;
            f32x4 bv[2][2];
#pragma unroll
            for (int bj = 0; bj < 2; ++bj)
#pragma unroll
                for (int n = 0; n < 2; ++n) bv[bj][n] = *(const f32x4*)(gb + bj * DM + 4 * n + lc) * (-1.4426950408889634f);
#pragma unroll
            for (int ai = 0; ai < 2; ++ai)
#pragma unroll
                for (int m = 0; m < 4; ++m) {
                    const float r = rs[ai * 4 + m] * (-1.4426950408889634f);
                    f32x4 rr[2], gg[2];
#pragma unroll
                    for (int n = 0; n < 2; ++n) { const f32x4 xa = acc[ai][0][m][n] * r + bv[0][n], xs_ = acc[ai][1][m][n] * r + bv[1][n];
#pragma unroll
                        for (int h = 0; h < 2; ++h) { f32x2 ea, ds;
                            ea.x = __builtin_amdgcn_exp2f(xa[2 * h]); ea.y = __builtin_amdgcn_exp2f(xa[2 * h + 1]);
                            ds.x = __builtin_amdgcn_exp2f(fminf(xs_[2 * h], 100.f)); ds.y = __builtin_amdgcn_exp2f(fminf(xs_[2 * h + 1], 100.f));
                            ea = ea + 1.0f; ds = ds + 1.0f;
                            f32x2 ra, rd; ra.x = __builtin_amdgcn_rcpf(ea.x); ra.y = __builtin_amdgcn_rcpf(ea.y); rd.x = __builtin_amdgcn_rcpf(ds.x); rd.y = __builtin_amdgcn_rcpf(ds.y);
                            const f32x2 rt = ds * ra; gg[n][2 * h] = rd.x; gg[n][2 * h + 1] = rd.y; rr[n][2 * h] = rt.x; rr[n][2 * h + 1] = rt.y; } }
                    *(u32x4*)(dR + (ai * 128 + m * 16) * DM + lo) = pack8(rr[0], rr[1]); *(u32x4*)(dS + (ai * 128 + m * 16) * DM + lo) = pack8(gg[0], gg[1]);
                }
        }
    }
};

struct EpiBranch {
    static constexpr bool MID = true; static constexpr int NVM = 32;
    __device__ __forceinline__ void mid(AccT& acc, const pg8::Unit& u, int wr, int wc, int fr, int fq) const {
        unsigned char* ws = get_args()->ws; const size_t uo = (size_t)(u.pm * 256 + wr * 64) * DM + u.pn * 256; const unsigned lo = (unsigned)fr * DM + 32 * wc + 8 * fq;
        const bf16_t* GA = (const bf16_t*)(ws + WS_GA) + uo;
        u32x4 ga[2][4][2];
#pragma unroll
        for (int ai = 0; ai < 2; ++ai)
#pragma unroll
            for (int m = 0; m < 4; ++m)
#pragma unroll
                for (int bj = 0; bj < 2; ++bj) ga[ai][m][bj] = *(const u32x4*)(GA + (ai * 128 + m * 16) * DM + bj * 128 + lo);
#pragma unroll
        for (int ai = 0; ai < 2; ++ai)
#pragma unroll
            for (int m = 0; m < 4; ++m)
#pragma unroll
                for (int bj = 0; bj < 2; ++bj)
#pragma unroll
                    for (int q = 0; q < 4; ++q) { acc[ai][bj][m][q >> 1][(q & 1) * 2] *= bf_lo(ga[ai][m][bj][q]); acc[ai][bj][m][q >> 1][(q & 1) * 2 + 1] *= bf_hi(ga[ai][m][bj][q]); }
        asm volatile("" ::: "memory");
    }
    __device__ __forceinline__ void operator()(const AccT& acc, const pg8::Unit& u, int wr, int wc, int fr, int fq) const {
        unsigned char* ws = get_args()->ws; const size_t uo = (size_t)(u.pm * 256 + wr * 64) * DM + u.pn * 256; const unsigned lo = (unsigned)fr * DM + 32 * wc + 8 * fq;
        const bf16_t* GS = (const bf16_t*)(ws + WS_GS) + uo; bf16_t* MRG = (bf16_t*)(ws + WS_MRG) + uo;
#pragma unroll
        for (int ai = 0; ai < 2; ++ai) {
            u32x4 gs[4][2];
#pragma unroll
            for (int m = 0; m < 4; ++m)
#pragma unroll
                for (int bj = 0; bj < 2; ++bj) gs[m][bj] = *(const u32x4*)(GS + (ai * 128 + m * 16) * DM + bj * 128 + lo);
#pragma unroll
            for (int m = 0; m < 4; ++m)
#pragma unroll
                for (int bj = 0; bj < 2; ++bj) { const u32x4 s = gs[m][bj]; f32x4 v0 = acc[ai][bj][m][0], v1 = acc[ai][bj][m][1];
                    v0[0] *= fmaxf(bf_lo(s[0]), 1e-30f); v0[1] *= fmaxf(bf_hi(s[0]), 1e-30f); v0[2] *= fmaxf(bf_lo(s[1]), 1e-30f); v0[3] *= fmaxf(bf_hi(s[1]), 1e-30f);
                    v1[0] *= fmaxf(bf_lo(s[2]), 1e-30f); v1[1] *= fmaxf(bf_hi(s[2]), 1e-30f); v1[2] *= fmaxf(bf_lo(s[3]), 1e-30f); v1[3] *= fmaxf(bf_hi(s[3]), 1e-30f);
                    *(u32x4*)(MRG + (ai * 128 + m * 16) * DM + bj * 128 + lo) = pack8(v0, v1); } }
    }
};

struct EpiResid {
    static constexpr bool MID = false; static constexpr int NVM = 32;
    int first, last;
    __device__ __forceinline__ void operator()(const AccT& acc, const pg8::Unit& u, int wr, int wc, int fr, int fq) const {
        unsigned char* ws = get_args()->ws; const size_t uo = (size_t)(u.pm * 256 + wr * 64) * DM + u.pn * 256; const unsigned lo = (unsigned)fr * DM + 32 * wc + 8 * fq;
        float* X = (float*)(ws + WS_X) + uo; bf16_t* XB = (bf16_t*)(ws + WS_XB) + uo; float* ssq = (float*)(ws + WS_SSQ); LAS f32x2* xs = (LAS f32x2*)(lds_base() + XS_OFF);
        const float* base = get_args()->x + uo;
        const int rl0 = wr * 64 + fr;
#pragma unroll
        for (int ai = 0; ai < 2; ++ai) {
            f32x4 bs[4][2][2];
            if (first) {
#pragma unroll
                for (int m = 0; m < 4; ++m)
#pragma unroll
                    for (int bj = 0; bj < 2; ++bj) { const int ro = (ai * 128 + m * 16) * DM + bj * 128; bs[m][bj][0] = *(const f32x4*)(base + ro + lo); bs[m][bj][1] = *(const f32x4*)(base + ro + 4 + lo); }
            } else {
                u32x4 bb[4][2];
#pragma unroll
                for (int m = 0; m < 4; ++m)
#pragma unroll
                    for (int bj = 0; bj < 2; ++bj) bb[m][bj] = *(const u32x4*)(XB + (ai * 128 + m * 16) * DM + bj * 128 + lo);
#pragma unroll
                for (int m = 0; m < 4; ++m)
#pragma unroll
                    for (int bj = 0; bj < 2; ++bj) { const u32x4 b = bb[m][bj];
                        bs[m][bj][0] = (f32x4){bf_lo(b[0]), bf_hi(b[0]), bf_lo(b[1]), bf_hi(b[1])}; bs[m][bj][1] = (f32x4){bf_lo(b[2]), bf_hi(b[2]), bf_lo(b[3]), bf_hi(b[3])}; }
            }
#pragma unroll
            for (int m = 0; m < 4; ++m) { float s2 = 0.f;
#pragma unroll
                for (int bj = 0; bj < 2; ++bj) { const int ro = (ai * 128 + m * 16) * DM + bj * 128;
                    const f32x4 v0 = bs[m][bj][0] + acc[ai][bj][m][0], v1 = bs[m][bj][1] + acc[ai][bj][m][1];
                    if (last) { *(f32x4*)(X + ro + lo) = v0; *(f32x4*)(X + ro + 4 + lo) = v1; }
                    else *(u32x4*)(XB + ro + lo) = pack8(v0, v1);
                    s2 += ((v0[0] * v0[0] + v0[1] * v0[1]) + (v0[2] * v0[2] + v0[3] * v0[3])) + ((v1[0] * v1[0] + v1[1] * v1[1]) + (v1[2] * v1[2] + v1[3] * v1[3])); }
                s2 = sum_x16_x32(s2);
                if (fq == 0) xs[(rl0 + ai * 128 + m * 16) * 4 + wc] = (f32x2){s2, 0.f}; } }
        EPI_BAR();
        const int t = 64 * (4 * wr + wc) + lane_id();
        if (t < 256) { const f32x2 a = xs[t * 4 + 0], b = xs[t * 4 + 1], c = xs[t * 4 + 2], d = xs[t * 4 + 3]; ssq[(size_t)(u.pm * 256 + t) * 8 + u.pn] = (a.x + b.x) + (c.x + d.x); }
        EPI_BAR();
    }
};

struct EpiSwiglu {
    static constexpr bool MID = false; static constexpr int NVM = REP_P6_SKIPEPI ? 0 : 8;
    int pm0, skip;
    __device__ __forceinline__ void operator()(const AccT& acc, const pg8::Unit& u, int wr, int wc, int fr, int fq) const {
        if (skip) { if (acc[0][0][0][0][0] == 12345.678f) *(volatile float*)(get_args()->ws + WS_OH) = 1.f; return; }
        unsigned char* ws = get_args()->ws; bf16_t* HID = (bf16_t*)(ws + WS_HID) + (size_t)(u.pm * 256 + wr * 64) * FFH + u.pn * 128; const unsigned lo = (unsigned)fr * FFH + 32 * wc + 8 * fq;
        const int rl0 = wr * 64 + fr;
        float rs[8]; load_rstd(rs, (const float*)(ws + WS_SSQ), u.pm, pm0, rl0);
#pragma unroll
        for (int ai = 0; ai < 2; ++ai)
#pragma unroll
            for (int m = 0; m < 4; ++m) { const float r = rs[ai * 4 + m], rn = r * (-1.4426950408889634f), r2 = r * r;
                f32x2 a2[4], b2[4], den[4], rc[4], ab[4];
#pragma unroll
                for (int i = 0; i < 4; ++i) { a2[i] = (f32x2){acc[ai][0][m][i >> 1][(i & 1) * 2], acc[ai][0][m][i >> 1][(i & 1) * 2 + 1]}; b2[i] = (f32x2){acc[ai][1][m][i >> 1][(i & 1) * 2], acc[ai][1][m][i >> 1][(i & 1) * 2 + 1]}; }
#pragma unroll
                for (int i = 0; i < 4; ++i) { const f32x2 t = a2[i] * rn; den[i].x = __builtin_amdgcn_exp2f(t.x); den[i].y = __builtin_amdgcn_exp2f(t.y); }
                __builtin_amdgcn_sched_barrier(0);
#pragma unroll
                for (int i = 0; i < 4; ++i) ab[i] = (a2[i] * b2[i]) * r2;
                __builtin_amdgcn_sched_barrier(0);
#pragma unroll
                for (int i = 0; i < 4; ++i) { den[i] = den[i] + 1.0f; rc[i].x = __builtin_amdgcn_rcpf(den[i].x); rc[i].y = __builtin_amdgcn_rcpf(den[i].y); }
                __builtin_amdgcn_sched_barrier(0);
                f32x4 o[2];
#pragma unroll
                for (int i = 0; i < 4; ++i) { const f32x2 res = ab[i] * rc[i]; o[i >> 1][(i & 1) * 2] = res.x; o[i >> 1][(i & 1) * 2 + 1] = res.y; }
                *(u32x4*)(HID + (ai * 128 + m * 16) * FFH + lo) = pack8(o[0], o[1]); }
    }
};

namespace att {
using bf16 = __hip_bfloat16;
constexpr int D = 128;
constexpr float THR = 8.f;
constexpr bool WSKIP = false;
constexpr float SCALE = 0.08838834764831845f;
constexpr float QSC = 1.4426950408889634f * SCALE;
constexpr float THR2 = THR * 1.4426950408889634f;
constexpr int NW = 8, QBLK = 32, KVBLK = 64, QB = NW * QBLK;
constexpr int SHM_V = KVBLK * D * 2, SHM_K = KVBLK * D * 2;
constexpr int LDS_ATT = 2 * SHM_V + 2 * SHM_K + NW * 64 * 4;
template <class A, class Bt> struct same_t { static constexpr bool v = false; };
template <class A> struct same_t<A, A> { static constexpr bool v = true; };
#define KSWZ(row, colB) ((row) * 256 + ((colB) ^ (((row) & 7) << 4)))
#define SBAR() __builtin_amdgcn_sched_barrier(0)
__device__ __forceinline__ int v_st(int k, int c) { const int kk = (k & ~0xC) | ((k & 4) << 1) | ((k & 8) >> 1); return ((kk >> 3) * 4 + (c >> 5)) * 512 + ((kk & 7) * 32 + (c & 31)) * 2; }
__device__ __forceinline__ int v_rd_base(int lane) { return ((lane & 3) << 3) | (((lane >> 2) & 3) << 6) | (((lane >> 4) & 1) << 5) | (((lane >> 5) & 1) << 11); }
constexpr int v_rd_off(int d0, int ks, int half) { return d0 * 512 + ks * 4096 + half * 2048; }
__device__ __forceinline__ int crow(int r, int hi) { return (r & 3) + 8 * (r >> 2) + 4 * hi; }
__device__ __forceinline__ unsigned cvtpk(float lo, float hi) { return cvt_pk_bf16(lo, hi); }
__device__ __forceinline__ bf16x8 pack8(f32x4 a, f32x4 b) { u32x4 w = {cvtpk(a[0], a[1]), cvtpk(a[2], a[3]), cvtpk(b[0], b[1]), cvtpk(b[2], b[3])}; return *reinterpret_cast<bf16x8*>(&w); }
template <class T> __device__ __forceinline__ bf16x8 load8(const T* p) {
    if constexpr (same_t<T, float>::v) { return pack8(*(const f32x4*)p, *(const f32x4*)(p + 4)); }
    else { return *reinterpret_cast<const bf16x8*>(p); }
}
__device__ __forceinline__ void mask_tile(f32x16& p0, f32x16& p1, int dq, unsigned W) {
    const float NEG = -__builtin_inff();
#pragma unroll
    for (int r = 0; r < 16; ++r) {
        const int c = (r & 3) + 8 * (r >> 2);
        if ((unsigned)(dq - c) >= W) p0[r] = NEG;
        if ((unsigned)(dq - c - 32) >= W) p1[r] = NEG;
    }
}
__device__ __forceinline__ void partialSM(f32x16& p0, f32x16& p1, float& m_reg, f32x16& cneg, bool first, float& alpha) {
    float pm_[4] = {p0[0], p0[1], p0[2], p0[3]};
    for (int r = 4; r < 16; ++r) pm_[r & 3] = fmaxf(pm_[r & 3], p0[r]); for (int r = 0; r < 16; ++r) pm_[r & 3] = fmaxf(pm_[r & 3], p1[r]);
    float pmax = fmaxf(fmaxf(pm_[0], pm_[1]), fmaxf(pm_[2], pm_[3]));
    if (__builtin_expect(!first && __all(pmax <= THR2), 1)) { alpha = 1.f; }
    else { { auto rr = __builtin_amdgcn_permlane32_swap(__float_as_uint(pmax), __float_as_uint(pmax), false, false);
             pmax = fmaxf(__uint_as_float(rr[0]), __uint_as_float(rr[1])); }
        const float dl = first ? fmaxf(pmax, -1.0e4f) : fmaxf(pmax, 0.f);
        alpha = first ? 1.f : __builtin_amdgcn_exp2f(-dl); m_reg += dl;
        for (int r = 0; r < 16; ++r) { p0[r] -= dl; p1[r] -= dl; }
        const float nm = -m_reg; for (int r = 0; r < 16; ++r) cneg[r] = nm; }
    for (int r = 0; r < 16; ++r) p0[r] = __builtin_amdgcn_exp2f(p0[r]);
}
__device__ __forceinline__ void finishSM(f32x16& p0, f32x16& p1, float alpha, float& l_reg, bf16x8& pa0, bf16x8& pa1, bf16x8& pa2, bf16x8& pa3) {
    for (int r = 0; r < 16; ++r) p1[r] = __builtin_amdgcn_exp2f(p1[r]);
    float ps_[4] = {p0[0], p0[1], p0[2], p0[3]}; for (int r = 4; r < 16; ++r) ps_[r & 3] += p0[r]; for (int r = 0; r < 16; ++r) ps_[r & 3] += p1[r];
    const float ps = (ps_[0] + ps_[1]) + (ps_[2] + ps_[3]);
    l_reg = l_reg * alpha + ps;
#define PK4(P, B_, OUT) do { u32x4 w = {cvtpk(P[B_+0], P[B_+1]), cvtpk(P[B_+2], P[B_+3]), cvtpk(P[B_+4], P[B_+5]), cvtpk(P[B_+6], P[B_+7])}; OUT = *reinterpret_cast<bf16x8*>(&w); } while (0)
    PK4(p0, 0, pa0); PK4(p0, 8, pa1); PK4(p1, 0, pa2); PK4(p1, 8, pa3);
#undef PK4
}
template <int KB, bool SK>
__device__ __forceinline__ void qkt(f32x16& p0, f32x16& p1, const char* K_lds, int r32, int hi, const bf16x8* qr, bool act) {
    if (SK && !act) { const float NEG = -__builtin_inff();
#pragma unroll
        for (int r = 0; r < 16; ++r) { p0[r] = NEG; p1[r] = NEG; } return; }
    p0 = f32x16{}; p1 = f32x16{};
    const char* kb[4];
#pragma unroll
    for (int dd = 0; dd < 4; ++dd) kb[dd] = K_lds + KB * SHM_K + KSWZ(r32, (dd * 16 + hi * 8) * 2);
#pragma unroll
    for (int d0 = 0; d0 < 8; ++d0) { const char* a = kb[d0 & 3] + (d0 >> 2) * 128;
        bf16x8 b0 = *reinterpret_cast<const bf16x8*>(a);
        bf16x8 b1 = *reinterpret_cast<const bf16x8*>(a + 32 * 256);
        p0 = __builtin_amdgcn_mfma_f32_32x32x16_bf16(b0, qr[d0], p0, 0, 0, 0);
        p1 = __builtin_amdgcn_mfma_f32_32x32x16_bf16(b1, qr[d0], p1, 0, 0, 0); }
}
template <int VB, bool SK>
__device__ __forceinline__ void pv_tile(f32x16* o, int vb0, bf16x8 pa0, bf16x8 pa1, bf16x8 pa2, bf16x8 pa3, bool act) {
    if (SK && !act) return;
#define TRRD(dst, off) asm volatile("ds_read_b64_tr_b16 %0, %1 offset:%2" : "=&v"(dst) : "v"(vb0), "i"(off) : "memory")
#define PV_D0(d0) do { s16x4 l0, l1, l2, l3, h0, h1, h2, h3; constexpr int b_ = VB * SHM_V + v_rd_off(d0, 0, 0); \
        TRRD(l0, b_); TRRD(h0, b_ + 256); TRRD(l1, b_ + 4096); TRRD(h1, b_ + 4352); TRRD(l2, b_ + 8192); TRRD(h2, b_ + 8448); TRRD(l3, b_ + 12288); TRRD(h3, b_ + 12544); \
        asm volatile("s_waitcnt lgkmcnt(0)" ::: "memory"); SBAR();   \
        o[d0] = __builtin_amdgcn_mfma_f32_32x32x16_bf16(pa0, (bf16x8){l0[0], l0[1], l0[2], l0[3], h0[0], h0[1], h0[2], h0[3]}, o[d0], 0, 0, 0);   \
        o[d0] = __builtin_amdgcn_mfma_f32_32x32x16_bf16(pa1, (bf16x8){l1[0], l1[1], l1[2], l1[3], h1[0], h1[1], h1[2], h1[3]}, o[d0], 0, 0, 0);   \
        o[d0] = __builtin_amdgcn_mfma_f32_32x32x16_bf16(pa2, (bf16x8){l2[0], l2[1], l2[2], l2[3], h2[0], h2[1], h2[2], h2[3]}, o[d0], 0, 0, 0);   \
        o[d0] = __builtin_amdgcn_mfma_f32_32x32x16_bf16(pa3, (bf16x8){l3[0], l3[1], l3[2], l3[3], h3[0], h3[1], h3[2], h3[3]}, o[d0], 0, 0, 0); } while (0)
    PV_D0(0); PV_D0(1); PV_D0(2); PV_D0(3);
#undef PV_D0
#undef TRRD
}
#undef KSWZ
#undef SBAR
}

namespace datt {
using namespace att;
constexpr int STAGE = 65536, K_OFF = 0, V_OFF = 32768;
#define DSBAR() __builtin_amdgcn_sched_barrier(0)
#define DKSWZ(row, colB) ((row) * 256 + ((colB) ^ (((row) & 7) << 4)))
__device__ __forceinline__ void qkt_rt(f32x16& p0, f32x16& p1, int Kt  , int r32, int hi, const bf16x8* qr, const f32x16& cneg  ) {
    int kb[4];
#pragma unroll
    for (int dd = 0; dd < 4; ++dd) kb[dd] = Kt + DKSWZ(r32, (dd * 16 + hi * 8) * 2);
#define KRD(dst, a_, off) asm volatile("ds_read_b128 %0, %1 offset:%2" : "=&v"(dst) : "v"(a_), "i"(off) : "memory")
#define KWAIT(n) asm volatile("s_waitcnt lgkmcnt(" #n ")" ::: "memory")
    bf16x8 a0, a1, b0, b1;
    KRD(a0, kb[0], 0); KRD(a1, kb[0], 8192); KRD(b0, kb[1], 0); KRD(b1, kb[1], 8192);
#define QSTEP(d0, X0, X1, nd, NXT) do { if (NXT) KWAIT(2); else KWAIT(0); DSBAR(); \
        p0 = __builtin_amdgcn_mfma_f32_32x32x16_bf16(X0, qr[d0], p0, 0, 0, 0); p1 = __builtin_amdgcn_mfma_f32_32x32x16_bf16(X1, qr[d0], p1, 0, 0, 0); DSBAR(); \
        if (NXT) { KRD(X0, kb[(nd) & 3], ((nd) >> 2) * 128); KRD(X1, kb[(nd) & 3], ((nd) >> 2) * 128 + 8192); } } while (0)
    KWAIT(2); DSBAR(); p0 = __builtin_amdgcn_mfma_f32_32x32x16_bf16(a0, qr[0], cneg, 0, 0, 0); p1 = __builtin_amdgcn_mfma_f32_32x32x16_bf16(a1, qr[0], cneg, 0, 0, 0); DSBAR(); KRD(a0, kb[2 & 3], (2 >> 2) * 128); KRD(a1, kb[2 & 3], (2 >> 2) * 128 + 8192);
    QSTEP(1, b0, b1, 3, 1); QSTEP(2, a0, a1, 4, 1); QSTEP(3, b0, b1, 5, 1);
    QSTEP(4, a0, a1, 6, 1); QSTEP(5, b0, b1, 7, 1);
    KWAIT(2); DSBAR(); p0 = __builtin_amdgcn_mfma_f32_32x32x16_bf16(a0, qr[6], p0, 0, 0, 0); p1 = __builtin_amdgcn_mfma_f32_32x32x16_bf16(a1, qr[6], p1, 0, 0, 0);
    KWAIT(0); DSBAR(); p0 = __builtin_amdgcn_mfma_f32_32x32x16_bf16(b0, qr[7], p0, 0, 0, 0); p1 = __builtin_amdgcn_mfma_f32_32x32x16_bf16(b1, qr[7], p1, 0, 0, 0);
#undef QSTEP
#undef KWAIT
#undef KRD
}
template <int MODE>
__device__ __forceinline__ void dattn_unit(const bf16_t* QH, const bf16_t* KH, const bf16_t* VH, bf16_t* A2, int bh, int qb, float lamf  , const float* gain  , int lay  , char* lds, float* scr, const int tid, const int rot  ) {
    int tid_ = tid; asm volatile("" : "+v"(tid_));
    const int wid = __builtin_amdgcn_readfirstlane(tid_ >> 6), lane = tid_ & 63, r32 = lane & 31, hi = lane >> 5, c = wid >> 2, p = wid & 3;
    const int row0 = qb * 128, qlo = row0 + 32 * p, qm = qlo + r32 - 4 * hi, NT = 2 * qb + 2;
    const bf16_t* Qc = QH + ((size_t)(bh * 2 + c) * SEQ + qlo) * HDIM; const char* Kc = (const char*)(KH + (size_t)(bh * 2 + c) * SEQ * HDIM);
    const char* V0 = (const char*)(VH + (size_t)(bh * 2) * SEQ * HDIM);
    float* li_l = scr + wid * 64, * al_l = li_l + 32;
    const char* K1h = (const char*)(KH + (size_t)(bh * 2) * SEQ * HDIM); const char* K2h = K1h + (size_t)SEQ * HDIM * 2; const char* V1 = V0 + (size_t)SEQ * HDIM * 2;
#define DMA16(g, l_) __builtin_amdgcn_global_load_lds((const unsigned*)(g), (LAS unsigned*)(l_), 16, 0, 0)
    unsigned koff0_, voff0_;
    { const int row_ = 8 * wid + (lane >> 4), ch_ = (lane & 15) ^ (row_ & 7); koff0_ = (unsigned)(row_ * 256 + ch_ * 16);
      const int kk_ = 8 * wid + ((lane & 31) >> 2), k_ = (kk_ & ~0xC) | ((kk_ & 4) << 1) | ((kk_ & 8) >> 1), cc_ = 32 * (lane >> 5) + 8 * (lane & 3); voff0_ = (unsigned)(k_ * 256 + cc_ * 2); }
#define STAGE_TILE(t_, st_) do { const size_t kb_ = (size_t)(t_) * 64 * 256; LAS unsigned char* sb_ = lds_base() + (st_) * STAGE; \
        const unsigned koff1_ = (koff0_ ^ 64u) + 1024u, voff1_ = voff0_ + 128u; \
        DMA16(K1h + kb_ + koff0_, sb_ + K_OFF + (8 * wid) * 256); DMA16(K2h + kb_ + koff0_, sb_ + K_OFF + 16384 + (8 * wid) * 256); \
        DMA16(V0 + kb_ + voff0_, sb_ + V_OFF + (2 * wid) * 1024); DMA16(V1 + kb_ + voff0_, sb_ + V_OFF + 16384 + (2 * wid) * 1024); \
        DMA16(K1h + kb_ + koff1_, sb_ + K_OFF + (8 * wid + 4) * 256); DMA16(K2h + kb_ + koff1_, sb_ + K_OFF + 16384 + (8 * wid + 4) * 256); \
        DMA16(V0 + kb_ + voff1_, sb_ + V_OFF + (2 * wid + 1) * 1024); DMA16(V1 + kb_ + voff1_, sb_ + V_OFF + 16384 + (2 * wid + 1) * 1024); } while (0)
    bf16x8 qr[8];
#pragma unroll
    for (int d0 = 0; d0 < 8; ++d0) qr[d0] = *reinterpret_cast<const bf16x8*>(Qc + (unsigned)(r32 * HDIM + d0 * 16 + hi * 8));
    if (MODE != 4) STAGE_TILE(rot, 0);
    float m_reg = 0.f, l_reg = 0.f; f32x16 o[8] = {};
    f32x16 cneg = {};
    f32x16 p0, p1; float alpha; bf16x8 pa0, pa1, pa2, pa3; bool fresh = true;
    const int vrb = v_rd_base(lane);
    for (int i = 0; i < NT; ++i) { int t = i + rot; if (t >= NT) t -= NT; int tn = t + 1; if (tn >= NT) tn = 0;
        asm volatile("s_waitcnt vmcnt(0)" ::: "memory"); __builtin_amdgcn_s_barrier(); asm volatile("" ::: "memory");
        const int kbase = t * 64; const bool act = kbase <= qlo + 31;
        if (MODE != 4 && i + 1 < NT) STAGE_TILE(tn, (i + 1) & 1);
        if (act) { const int Kt = (i & 1) * STAGE + K_OFF + c * 16384;
            DSBAR(); if (MODE != 3) qkt_rt(p0, p1, Kt, r32, hi, qr, cneg); else { p0 = f32x16{}; p1 = f32x16{}; } DSBAR(); }
        if (act) {
            if (kbase + 63 > qlo) mask_tile(p0, p1, qm - kbase, 0x7fffffffu);
            if (MODE != 1) { partialSM(p0, p1, m_reg, cneg, fresh, alpha); fresh = false;
            finishSM(p0, p1, alpha, l_reg, pa0, pa1, pa2, pa3); } else { alpha = 1.f; l_reg = 1.f; pa0 = att::pack8((f32x4){p0[0],p0[1],p0[2],p0[3]}, (f32x4){p0[4],p0[5],p0[6],p0[7]}); pa1 = att::pack8((f32x4){p0[8],p0[9],p0[10],p0[11]}, (f32x4){p0[12],p0[13],p0[14],p0[15]}); pa2 = att::pack8((f32x4){p1[0],p1[1],p1[2],p1[3]}, (f32x4){p1[4],p1[5],p1[6],p1[7]}); pa3 = att::pack8((f32x4){p1[8],p1[9],p1[10],p1[11]}, (f32x4){p1[12],p1[13],p1[14],p1[15]}); } DSBAR();
            if (__any(alpha < 1.f)) { if (hi == 0) al_l[r32] = alpha; asm volatile("s_waitcnt lgkmcnt(0)" ::: "memory");
#pragma unroll
                for (int d_ = 0; d_ < 8; ++d_)
#pragma unroll
                    for (int r = 0; r < 16; ++r) o[d_][r] *= al_l[crow(r, hi)]; }
            const int vb = (i & 1) * STAGE + V_OFF + vrb;
            if (MODE != 2) { pv_tile<0, false>(o, vb, pa0, pa1, pa2, pa3, true); pv_tile<0, false>(o + 4, vb + 16384, pa0, pa1, pa2, pa3, true); } else { o[0][0] += __uint_as_float((unsigned)pa0[0] + (unsigned)pa1[0] + (unsigned)pa2[0] + (unsigned)pa3[0]); }
        }
    }
    { auto rr = __builtin_amdgcn_permlane32_swap(__float_as_uint(l_reg), __float_as_uint(l_reg), false, false); l_reg = __uint_as_float(rr[0]) + __uint_as_float(rr[1]); }
    if (hi == 0) li_l[r32] = (c ? lamf : 1.0f) * __builtin_amdgcn_rcpf(l_reg);
    asm volatile("s_waitcnt lgkmcnt(0)" ::: "memory");
    float rli[16];
#pragma unroll
    for (int r = 0; r < 16; ++r) rli[r] = li_l[crow(r, hi)];
    __builtin_amdgcn_s_barrier(); asm volatile("" ::: "memory");
    LAS float* ex = (LAS float*)(lds_base() + p * 32768);
    if (c == 1) {
#pragma unroll
        for (int d0 = 0; d0 < 8; ++d0)
#pragma unroll
            for (int r = 0; r < 16; ++r) ex[crow(r, hi) * 256 + d0 * 32 + r32] = o[d0][r] * rli[r];
    }
    asm volatile("s_waitcnt lgkmcnt(0)" ::: "memory"); __builtin_amdgcn_s_barrier(); asm volatile("" ::: "memory");
    if (c == 0) {
#pragma unroll
        for (int d0 = 0; d0 < 8; ++d0)
#pragma unroll
            for (int r = 0; r < 16; ++r) { const int a = crow(r, hi) * 256 + d0 * 32 + r32; ex[a] = o[d0][r] * rli[r] - ex[a]; }
    }
    asm volatile("s_waitcnt lgkmcnt(0)" ::: "memory"); __builtin_amdgcn_s_barrier(); asm volatile("" ::: "memory");
    {
        const int b = bh >> 3, h = bh & 7;
        bf16_t* outp = A2 + ((size_t)(b * SEQ + row0 + 16 * wid)) * KBR + h * 256;
        int lay_ = lay; asm volatile("" : "+s"(lay_));
        const float gsc_ = 1.0f - (0.8f - 0.6f * expf(-0.3f * (float)lay_));
        const f32x4 gain4 = *(const f32x4*)(gain + 4 * lane) * gsc_;
#pragma unroll 4
        for (int i = 0; i < 16; ++i) { const int R = 16 * wid + i;
            const f32x4 x = *(const LAS f32x4*)(lds_base() + (R >> 5) * 32768 + (R & 31) * 1024 + lane * 16);
            const float ss = wave_sum((x[0] * x[0] + x[1] * x[1]) + (x[2] * x[2] + x[3] * x[3]), lane);
            const float rs = __builtin_amdgcn_rsqf(ss * (1.0f / 256.0f) + EPS); const f32x4 y = x * rs * gain4;
            u32x2 w; w.x = cvt_pk_bf16(y[0], y[1]); w.y = cvt_pk_bf16(y[2], y[3]); *(u32x2*)(outp + (size_t)i * KBR + (unsigned)(4 * lane)) = w; }
    }
    asm volatile("s_waitcnt lgkmcnt(0)" ::: "memory"); __builtin_amdgcn_s_barrier(); asm volatile("" ::: "memory");
#undef STAGE_TILE
#undef DMA16
}

#undef DSBAR
#undef DKSWZ
}

#define XB_TMO      128
#define XB_XCNT(j)  (256  + 64 * (j))
#define XB_XSUB(j)  (1280 + 64 * (j))
#define XB_XGEN(j)  (2304 + 64 * (j))
#define XB_TOP      3328
#define XB_TOPGEN   3392
#define XCD_BAR_WORDS 3456
#define XB_SPIN_CAP (1u << 18)
__device__ __forceinline__ unsigned xb_ld(unsigned* p)              { return __hip_atomic_load(p, __ATOMIC_RELAXED, __HIP_MEMORY_SCOPE_AGENT); }
__device__ __forceinline__ unsigned xb_add(unsigned* p, unsigned v) { return __hip_atomic_fetch_add(p, v, __ATOMIC_RELAXED, __HIP_MEMORY_SCOPE_AGENT); }
__device__ __forceinline__ unsigned xb_xcc_id() { return (unsigned)__builtin_amdgcn_s_getreg((3 << 11) | 20) & 0xFu; }
#define XB_SPIN(cond, bar) do { unsigned _sp = 0; while (cond) { __builtin_amdgcn_s_sleep(1); \
    if ((++_sp & 255u) == 0u) { if (xb_ld(&(bar)[XB_TMO])) break; if (_sp > XB_SPIN_CAP) { atomicAdd(&(bar)[XB_TMO], 1u); break; } } } } while (0)
struct XcdBarrier { unsigned* bar; unsigned x; volatile LAS unsigned* st; };
__device__ __forceinline__ XcdBarrier xcd_barrier_post(unsigned* bar, volatile LAS unsigned* st, const bool leader) {
    XcdBarrier b; b.bar = bar; b.x = xb_xcc_id(); b.st = st;
    if (leader) (void)xb_add(&bar[XB_XCNT(b.x)], 1u);
    return b;
}
__device__ __forceinline__ void xcd_barrier_complete(unsigned* bar, unsigned x, unsigned& nloc, unsigned& nx) {
    const unsigned G = gridDim.x * gridDim.y * gridDim.z;
    unsigned sum, cnt, mine, sp = 0u;
    for (;;) {
        sum = 0u; cnt = 0u; mine = 0u;
#pragma unroll
        for (unsigned j = 0; j < 16; ++j) { const unsigned c = xb_ld(&bar[XB_XCNT(j)]); sum += c; cnt += (c > 0u) ? 1u : 0u; mine = (j == x) ? c : mine; }
        if (sum == G) break;
        __builtin_amdgcn_s_sleep(1);
        if ((++sp & 255u) == 0u) { if (xb_ld(&bar[XB_TMO])) break; if (sp > XB_SPIN_CAP) { atomicAdd(&bar[XB_TMO], 1u); break; } }
    }
    nloc = mine > 0u ? mine : 1u; nx = cnt > 0u ? cnt : 1u;
}
__device__ __forceinline__ void xcd_barrier(const XcdBarrier& b, const bool leader) {
    asm volatile("s_waitcnt vmcnt(0)" ::: "memory");
    __syncthreads();
    if (leader) {
        unsigned* bar = b.bar;
        __builtin_amdgcn_s_waitcnt(0);
        unsigned nloc = b.st[0], nx = b.st[1];
        if (nloc == 0u) { xcd_barrier_complete(bar, b.x, nloc, nx); b.st[0] = nloc; b.st[1] = nx; }
        const unsigned old = xb_add(&bar[XB_XSUB(b.x)], 1u);
        const unsigned gen = old / nloc;
        if (old + 1u == (gen + 1u) * nloc) {
            __builtin_amdgcn_fence(__ATOMIC_RELEASE, "agent");
            asm volatile("s_waitcnt vmcnt(0)" ::: "memory");
            const unsigned og = xb_add(&bar[XB_TOP], 1u);
            const unsigned tg = og / nx;
            if (og + 1u == (tg + 1u) * nx) xb_add(&bar[XB_TOPGEN], 1u);
            else XB_SPIN(xb_ld(&bar[XB_TOPGEN]) == tg, bar);
            __builtin_amdgcn_fence(__ATOMIC_ACQUIRE, "agent");
            xb_add(&bar[XB_XGEN(b.x)], 1u);
            asm volatile("s_waitcnt vmcnt(0)" ::: "memory");
        } else {
            XB_SPIN(xb_ld(&bar[XB_XGEN(b.x)]) == gen, bar);
            __builtin_amdgcn_fence(__ATOMIC_ACQUIRE, "agent");
            asm volatile("s_waitcnt vmcnt(0)" ::: "memory");
        }
    }
    __syncthreads();
}

struct TrItem { const float* W; const float* gain; bf16_t* WT; int ldw, src0, ldo, n0, kcol0, k0; float osc; };
__device__ __forceinline__ void transpose_load(const TrItem& d, f32x4 (&v)[16], int lane) {
    const int rsub = lane >> 4, c4 = lane & 15;
    const float* wp = d.W + (size_t)(d.k0 + rsub) * d.ldw + d.src0; const unsigned lo = 4u * c4;
#pragma unroll
    for (int i = 0; i < 16; ++i) v[i] = __builtin_nontemporal_load((const f32x4*)(wp + (size_t)(4 * i) * d.ldw + lo));
}
__device__ __forceinline__ void transpose_finish(const TrItem& d, f32x4 (&v)[16], LAS float* scr, int lane) {
    const int rsub = lane >> 4, c4 = lane & 15;
    if (d.gain) {
#pragma unroll
        for (int i = 0; i < 16; ++i) v[i] = v[i] * (d.gain[d.k0 + 4 * i + rsub] * d.osc); }
#pragma unroll
    for (int i = 0; i < 16; ++i) { LAS float* p = scr + (4 * i + rsub) * 65 + 4 * c4; p[0] = v[i][0]; p[1] = v[i][1]; p[2] = v[i][2]; p[3] = v[i][3]; }
    asm volatile("s_waitcnt lgkmcnt(0)" ::: "memory");
    const int c = lane & 7, nl = lane >> 3;
    bf16_t* op = d.WT + (size_t)d.n0 * d.ldo + d.kcol0 + d.k0; const unsigned so = (unsigned)nl * d.ldo + 8u * c;
#pragma unroll
    for (int j = 0; j < 8; ++j) { const LAS float* sp = scr + (8 * c) * 65 + nl + 8 * j;
        u32x4 o; o.x = cvt_pk_bf16(sp[0 * 65], sp[1 * 65]); o.y = cvt_pk_bf16(sp[2 * 65], sp[3 * 65]); o.z = cvt_pk_bf16(sp[4 * 65], sp[5 * 65]); o.w = cvt_pk_bf16(sp[6 * 65], sp[7 * 65]);
        *(u32x4*)(op + (size_t)(8 * j) * d.ldo + so) = o; }
    asm volatile("s_waitcnt lgkmcnt(0)" ::: "memory");
}
__device__ __forceinline__ int src_in(int n) {
    if (n >= 10240) { const int g = (n - 10240) >> 8, w = n & 255; return 10240 + (w >> 7) * 2048 + g * 128 + (w & 127); }
    if (n >= 4096) return n;
    const int r = n >> 11, nn = n & 2047, h = nn >> 8, w = nn & 255, bj = w >> 7, c = (w >> 6) & 1, d = w & 63;
    return r * 2048 + h * 256 + c * 128 + bj * 64 + d;
}
__device__ __forceinline__ int src_ffi(int n) { const int pn = n >> 8, w = n & 255, bj = w >> 7, p = w & 127; return bj * FFH + pn * 128 + p; }

#define PH_ARGS() ArgP ap = get_args(); unsigned char* ws = ap->ws; (void)ws; int bid_ = blockIdx.x, G_ = gridDim.x; asm volatile("" : "+s"(bid_), "+s"(G_)); (void)bid_; (void)G_
__global__ void __launch_bounds__(512, 2) mk_fwd(Args args_unused) {
    LAS unsigned char* lds = lds_base();
    volatile LAS unsigned* MISC = (volatile LAS unsigned*)(lds + MISC_OFF);
    const int wv = __builtin_amdgcn_readfirstlane((int)threadIdx.x >> 6);
    for (int u = TID_OF(wv); u < (LDS_BYTES - MISC_OFF) / 4; u += 512) MISC[u] = 0u;
    __syncthreads();
    XcdBarrier bar; bar.bar = nullptr; bar.x = 0; bar.st = nullptr;
    if (!MK_MULTI) { ArgP ap0 = get_args(); bar = xcd_barrier_post((unsigned*)(ap0->ws + WS_CTL) + CW_BAR, MISC + 8, TID_OF(wv) == 0); }
    int lo, hi; { ArgP ap0 = get_args(); lo = ap0->ph_lo; hi = ap0->ph_hi; }
#define IN(k) (lo <= (k) && (k) < hi && (DBG_CUT == 0 || (k) < DBG_CUT || (k) == 29))
#define GRID_BAR(k) do { if (IN(k) && IN((k) + 1)) xcd_barrier(bar, TID_OF(wv) == 0); } while (0)

    for (int rep = 0; rep < REP_P0; ++rep)
    if (EN_P0 && IN(0)) {
        PH_ARGS();
        const int tid = TID_OF(wv), lane = tid & 63, wid = wv, G = gridDim.x, bid = blockIdx.x, gw = bid * 8 + wid, NGW = G * 8;
        LAS float* scr = (LAS float*)(lds + wid * 16640);
        constexpr int NB_IN = INCOLS / 64, NB_D = DM / 64, NB_FI = 2 * FFH / 64, KB_D = DM / 64, KB_FO = FFH / 64;
        constexpr int I_IN = KB_D * NB_IN, I_BR = KB_D * NB_D, I_OUT = I_BR, I_FI = KB_D * NB_FI, I_FO = KB_FO * NB_D;
        constexpr int I_LAYER = I_IN + 2 * I_BR + I_OUT + I_FI + I_FO;
        auto decode = [&](int it) -> TrItem { const int l = it / I_LAYER; int r = it - l * I_LAYER; TrItem d;
            if (r < I_IN) { const int kb = r / NB_IN, nb = r - kb * NB_IN, n0 = nb * 64;
                d = TrItem{ap->w_in + (size_t)l * DM * INCOLS, ap->norm_attn + l * DM, (bf16_t*)(ws + WS_WIN + l * SZ_WIN), INCOLS, src_in(n0), DM, n0, 0, kb * 64, n0 < DM ? att::QSC : 1.0f}; return d; }
            r -= I_IN;
            if (r < 2 * I_BR) { const int br = r / I_BR, rr = r - br * I_BR, kb = rr / NB_D, nb = rr - kb * NB_D, n0 = nb * 64;
                d = TrItem{ap->w_branch + ((size_t)l * 2 + br) * DM * DM, nullptr, (bf16_t*)(ws + WS_WBR + l * SZ_WBR), DM, n0, KBR, n0, br * DM, kb * 64, 1.0f}; return d; }
            r -= 2 * I_BR;
            if (r < I_OUT) { const int kb = r / NB_D, nb = r - kb * NB_D, n0 = nb * 64;
                d = TrItem{ap->w_out + (size_t)l * DM * DM, nullptr, (bf16_t*)(ws + WS_WOUT + l * SZ_WOUT), DM, n0, DM, n0, 0, kb * 64, 1.0f}; return d; }
            r -= I_OUT;
            if (r < I_FI) { const int kb = r / NB_FI, nb = r - kb * NB_FI, n0 = nb * 64;
                d = TrItem{ap->w_ffn_in + (size_t)l * DM * 2 * FFH, ap->norm_ffn + l * DM, (bf16_t*)(ws + WS_WFI + l * SZ_WFI), 2 * FFH, src_ffi(n0), DM, n0, 0, kb * 64, 1.0f}; return d; }
            r -= I_FI;
            { const int kb = r / NB_D, nb = r - kb * NB_D, n0 = nb * 64;
                d = TrItem{ap->w_ffn_out + (size_t)l * FFH * DM, nullptr, (bf16_t*)(ws + WS_WFO + l * SZ_WFO), DM, n0, FFH, n0, 0, kb * 64, 1.0f}; return d; } };
        for (int it = gw; it < DEPTH * I_LAYER; it += 2 * NGW) {
            const bool two = it + NGW < DEPTH * I_LAYER;
            const TrItem d0 = decode(it), d1 = decode(two ? it + NGW : it);
            f32x4 v0[16], v1[16];
            transpose_load(d0, v0, lane); if (two) transpose_load(d1, v1, lane);
            transpose_finish(d0, v0, scr, lane); if (two) transpose_finish(d1, v1, scr, lane);
        }
        { bf16_t* XB = (bf16_t*)(ws + WS_XB); float* SSQ = (float*)(ws + WS_SSQ); const float* x = ap->x;
        for (int m = gw; m < MTOK; m += NGW) {
            const f32x4* xr = (const f32x4*)(x + (size_t)m * DM) + lane; float s = 0.f;
#pragma unroll
            for (int j = 0; j < 8; ++j) { const f32x4 v = xr[64 * j]; s += (v[0] * v[0] + v[1] * v[1]) + (v[2] * v[2] + v[3] * v[3]);
                u32x2 w; w.x = cvt_pk_bf16(v[0], v[1]); w.y = cvt_pk_bf16(v[2], v[3]); *((u32x2*)(XB + (size_t)m * DM) + lane + 64 * j) = w; }
            s = wave_sum(s, lane);
            if (lane < 8) SSQ[(size_t)m * 8 + lane] = lane == 0 ? s : 0.f;
        } }
        { _Float16* COS = (_Float16*)(ws + WS_COS); _Float16* SIN = (_Float16*)(ws + WS_SIN); const int* pos = ap->pos;
        for (int i = bid * 512 + tid; i < MTOK * 64; i += G * 512) { const int m = i >> 6, d = i & 63;
            const float inv = powf(10000.0f, -(float)(2 * d) * (1.0f / 128.0f)); const float ang = (float)pos[m] * inv;
            const double t = (double)ang * 0.15915494309189535; const float fr = (float)(t - rint(t));
            COS[i] = (_Float16)__builtin_amdgcn_cosf(fr); SIN[i] = (_Float16)__builtin_amdgcn_sinf(fr); } }
        { bf16_t* WST = (bf16_t*)(ws + WS_WST); const float* wsp = ap->w_spatial;
        for (int i = bid * 512 + tid; i < DEPTH * 8 * 128 * 128; i += G * 512) { const int jj = i & 127, ii = (i >> 7) & 127; const float v = jj <= ii ? wsp[i] : 0.f; WST[i] = (bf16_t)(cvt_pk_bf16(v, 0.f) & 0xffffu); } }
    }
    GRID_BAR(0);

    for (int l = 0; l < DEPTH; ++l) {
        const int pb = 1 + 7 * l;
        for (int rep = 0; rep < REP_P1; ++rep)
        if (EN_P1 && IN(pb)) {
            PH_ARGS();
            pg8::Gemm g{(const bf16_t*)(ws + WS_XB), (const bf16_t*)(ws + WS_WIN + l * SZ_WIN), MTOK, INCOLS, DM}; pg8::StaticOrder S; S.init(MTOK, INCOLS, G_, bid_, DBG_ROT);
            pg8::Unit u0; const int pm0 = S.next(0, u0) ? u0.pm : -1;
            if (pm0 >= 0) panel_rstd_to_lds((const float*)(ws + WS_SSQ), pm0, TID_OF(wv));
            __syncthreads();
            EpiIn E{l, pm0};
            pg8::gemm_phase<EpiIn>(lds, g, S, E, wv);
        }
        GRID_BAR(pb);
        if (IN(pb + 1)) {
            for (int rep = 0; rep < REP_ATT; ++rep)
            if (EN_ATT) {
                PH_ARGS();
                const bf16_t* QH = (const bf16_t*)(ws + WS_QH); const bf16_t* KH = (const bf16_t*)(ws + WS_KH); const bf16_t* VH = (const bf16_t*)(ws + WS_VH); bf16_t* A2 = (bf16_t*)(ws + WS_A2);
                int tid = TID_OF(wv); asm volatile("" : "+v"(tid)); const int lane = tid & 63;
                const float lam_init = 0.8f - 0.6f * expf(-0.3f * (float)l);
                const float* lp = ap->lam + l * 512;
                const float s1 = wave_sum(lp[lane] * lp[128 + lane] + lp[64 + lane] * lp[192 + lane], lane), s2 = wave_sum(lp[256 + lane] * lp[384 + lane] + lp[320 + lane] * lp[448 + lane], lane);
                const float lamf = __int_as_float(__builtin_amdgcn_readfirstlane(__float_as_int(expf(s1) - expf(s2) + lam_init)));
                const float* gn = ap->subln + l * 256; const int gsc = l;
                float* scr = (float*)(lds_raw + XS_OFF);
                for (int L = bid_; L < 512; L += G_) { const int xcd = L & 7, k = L >> 3, x = k & 15, bh = (k >> 4) * 8 + xcd;
                    datt::dattn_unit<0>(QH, KH, VH, A2, bh, 31 - x, lamf, gn, gsc, (char*)lds_raw, scr, TID_OF(wv), ATT_ROT ? x : 0);
                    datt::dattn_unit<0>(QH, KH, VH, A2, bh, x, lamf, gn, gsc, (char*)lds_raw, scr, TID_OF(wv), 0);
#if ATT_PROBE
                    datt::dattn_unit<ATT_PROBE>(QH, KH, VH, (bf16_t*)(ws + WS_OH), bh, 31 - x, lamf, gn, gsc, (char*)lds_raw, scr, TID_OF(wv), ATT_ROT ? x : 0);
                    datt::dattn_unit<ATT_PROBE>(QH, KH, VH, (bf16_t*)(ws + WS_OH), bh, x, lamf, gn, gsc, (char*)lds_raw, scr, TID_OF(wv), 0);
#endif
                    }
            }
            __syncthreads();
            for (int rep = 0; rep < REP_SGU; ++rep)
            if (EN_SGU) {
                PH_ARGS();
                int tid_ = TID_OF(wv); asm volatile("" : "+v"(tid_));
                const int tid = tid_, lane = tid & 63, wid = wv;
                const float* LNST = (const float*)(ws + WS_LNST); const bf16_t* WST = (const bf16_t*)(ws + WS_WST); const bf16_t* GV = (const bf16_t*)(ws + WS_GV); const bf16_t* U = (const bf16_t*)(ws + WS_U); bf16_t* A2 = (bf16_t*)(ws + WS_A2);
                const float* ln_g = ap->sgu_ln_g + l * DM; const float* ln_b = ap->sgu_ln_b + l * DM; const float* b_sp = ap->b_spatial + l * 8 * 128;
                constexpr int WT_OFF = 0, XT_OFF = 34816, ST_OFF = 104448, RS = 272;
                LAS f32x2* ST = (LAS f32x2*)(lds + ST_OFF);
                const int r32 = lane & 31, hi = lane >> 5;
                for (int unit = bid_; unit < 1024; unit += G_) {
                    const int ch = unit >> 3, g = unit & 7, m0 = ch * 128;
                    if (tid < 128) { const f32x4* p = (const f32x4*)(LNST + (size_t)(m0 + tid) * 16); const f32x4 a = p[0], b = p[1], c = p[2], d = p[3];
                        const float s1 = ((a[0] + a[2]) + (b[0] + b[2])) + ((c[0] + c[2]) + (d[0] + d[2])), s2 = ((a[1] + a[3]) + (b[1] + b[3])) + ((c[1] + c[3]) + (d[1] + d[3]));
                        const float mean = s1 * (1.0f / DM), var = fmaxf(s2 * (1.0f / DM) - mean * mean, 0.f); ST[tid] = (f32x2){mean, 1.0f / sqrtf(var + EPS)}; }
                    { const bf16_t* wsrc = WST + (size_t)(l * 8 + g) * 128 * 128;
#pragma unroll
                        for (int i = 0; i < 4; ++i) { const int chunk = tid + 512 * i, row = chunk >> 4, cc = chunk & 15; *(LAS u32x4*)(lds + WT_OFF + row * RS + cc * 16) = *(const u32x4*)(wsrc + row * 128 + cc * 8); } }
                    __syncthreads();
                    { const int cg = wid * 4 + (lane & 3), c0 = g * 256 + cg * 8;
                        const f32x4 lg0 = *(const f32x4*)(ln_g + c0), lg1 = *(const f32x4*)(ln_g + c0 + 4), lb0 = *(const f32x4*)(ln_b + c0), lb1 = *(const f32x4*)(ln_b + c0 + 4);
#pragma unroll
                        for (int it = 0; it < 4; ++it) { const int j = 2 * (it * 16 + (lane >> 2));
                            const u32x4 v0 = *(const u32x4*)(GV + (size_t)(m0 + j) * DM + c0), v1 = *(const u32x4*)(GV + (size_t)(m0 + j + 1) * DM + c0);
                            const f32x2 st0 = ST[j], st1 = ST[j + 1];
#pragma unroll
                            for (int q = 0; q < 4; ++q) { const float ga = q < 2 ? lg0[2 * q] : lg1[2 * q - 4], gb = q < 2 ? lg0[2 * q + 1] : lg1[2 * q - 3], ba = q < 2 ? lb0[2 * q] : lb1[2 * q - 4], bb = q < 2 ? lb0[2 * q + 1] : lb1[2 * q - 3];
                                const float a0 = (bf_lo(v0[q]) - st0.x) * st0.y * ga + ba, a1 = (bf_lo(v1[q]) - st1.x) * st1.y * ga + ba;
                                const float b0 = (bf_hi(v0[q]) - st0.x) * st0.y * gb + bb, b1 = (bf_hi(v1[q]) - st1.x) * st1.y * gb + bb;
                                *(LAS unsigned*)(lds + XT_OFF + (cg * 8 + 2 * q) * RS + j * 2) = cvt_pk_bf16(a0, a1);
                                *(LAS unsigned*)(lds + XT_OFF + (cg * 8 + 2 * q + 1) * RS + j * 2) = cvt_pk_bf16(b0, b1); } } }
                    __syncthreads();
                    f32x16 acc[4] = {};
#pragma unroll
                    for (int ks = 0; ks < 8; ++ks) { const bf16x8 a = *(const LAS bf16x8*)(lds + XT_OFF + (32 * wid + r32) * RS + (16 * ks + 8 * hi) * 2);
#pragma unroll
                        for (int ib = 0; ib < 4; ++ib) if (ks <= 2 * ib + 1) { const bf16x8 b = *(const LAS bf16x8*)(lds + WT_OFF + (32 * ib + r32) * RS + (16 * ks + 8 * hi) * 2);
                            acc[ib] = __builtin_amdgcn_mfma_f32_32x32x16_bf16(a, b, acc[ib], 0, 0, 0); } }
#pragma unroll
                    for (int ib = 0; ib < 4; ++ib) { const int i = 32 * ib + r32; const float bs = b_sp[g * 128 + i];
#pragma unroll
                        for (int rg = 0; rg < 4; ++rg) { const int cc = g * 256 + 32 * wid + 8 * rg + 4 * hi;
                            const u32x2 uu = *(const u32x2*)(U + (size_t)(m0 + i) * DM + cc);
                            const f32x4 ug = gelu4((f32x4){bf_lo(uu.x), bf_hi(uu.x), bf_lo(uu.y), bf_hi(uu.y)});
                            u32x2 o; o.x = cvt_pk_bf16(ug[0] * (acc[ib][4 * rg] + bs), ug[1] * (acc[ib][4 * rg + 1] + bs)); o.y = cvt_pk_bf16(ug[2] * (acc[ib][4 * rg + 2] + bs), ug[3] * (acc[ib][4 * rg + 3] + bs));
                            *(u32x2*)(A2 + (size_t)(m0 + i) * KBR + DM + cc) = o; } }
                    __syncthreads();
                }
            }
        }
        GRID_BAR(pb + 1);
        for (int rep = 0; rep < REP_P4; ++rep)
        if (EN_P4 && IN(pb + 3)) {
            PH_ARGS();
            pg8::Gemm g{(const bf16_t*)(ws + WS_A2), (const bf16_t*)(ws + WS_WBR + l * SZ_WBR), MTOK, DM, KBR}; pg8::StaticOrder S; S.init(MTOK, DM, G_, bid_);
            EpiBranch E{};
            pg8::gemm_phase<EpiBranch>(lds, g, S, E, wv);
        }
        GRID_BAR(pb + 3);
        if (EN_P5 && IN(pb + 4)) {
            PH_ARGS();
            pg8::Gemm g{(const bf16_t*)(ws + WS_MRG), (const bf16_t*)(ws + WS_WOUT + l * SZ_WOUT), MTOK, DM, DM}; pg8::StaticOrder S; S.init(MTOK, DM, G_, bid_);
            EpiResid E{l == 0 ? 1 : 0, 0};
            pg8::gemm_phase<EpiResid>(lds, g, S, E, wv);
        }
        GRID_BAR(pb + 4);
        for (int rep = 0; rep < REP_P6; ++rep)
        if (EN_P6 && IN(pb + 5)) {
            PH_ARGS();
            pg8::Gemm g{(const bf16_t*)(ws + WS_XB), (const bf16_t*)(ws + WS_WFI + l * SZ_WFI), MTOK, 2 * FFH, DM}; pg8::StaticOrder S; S.init(MTOK, 2 * FFH, G_, bid_);
            pg8::Unit u0; const int pm0 = S.next(0, u0) ? u0.pm : -1;
            if (pm0 >= 0) panel_rstd_to_lds((const float*)(ws + WS_SSQ), pm0, TID_OF(wv));
            __syncthreads();
            EpiSwiglu E{pm0, (REP_P6_SKIPEPI && rep > 0) ? 1 : 0};
            pg8::gemm_phase<EpiSwiglu>(lds, g, S, E, wv);
        }
        GRID_BAR(pb + 5);
        if (EN_P7 && IN(pb + 6)) {
            PH_ARGS();
            pg8::Gemm g{(const bf16_t*)(ws + WS_HID), (const bf16_t*)(ws + WS_WFO + l * SZ_WFO), MTOK, DM, FFH}; pg8::StaticOrder S; S.init(MTOK, DM, G_, bid_);
            EpiResid E{0, l == DEPTH - 1 ? 1 : 0};
            pg8::gemm_phase<EpiResid>(lds, g, S, E, wv);
        }
        GRID_BAR(pb + 6);
    }
    if (DBG_CUT > 0) {
        if (IN(29)) { PH_ARGS(); float* out = ap->out; const int tid = TID_OF(wv);
            for (size_t i = (size_t)bid_ * 512 + tid; i < (size_t)MTOK * DM; i += (size_t)G_ * 512) { const size_t m = i >> 11, c = i & 2047; float v = 0.f;
                if (DBG_SRC == 1) { const bf16_t* A2 = (const bf16_t*)(ws + WS_A2); v = __uint_as_float((unsigned)A2[m * KBR + c] << 16) + __uint_as_float((unsigned)A2[m * KBR + DM + c] << 16); }
                if (DBG_SRC == 2) { const bf16_t* p = (const bf16_t*)(ws + WS_QH); v = __uint_as_float((unsigned)p[i] << 16) + __uint_as_float((unsigned)p[i + (size_t)MTOK * DM] << 16) + __uint_as_float((unsigned)p[i + 2 * (size_t)MTOK * DM] << 16); }
                if (DBG_SRC == 3) { const bf16_t* p = (const bf16_t*)(ws + WS_U); v = __uint_as_float((unsigned)p[i] << 16) + __uint_as_float((unsigned)p[i + (size_t)MTOK * DM] << 16) + __uint_as_float((unsigned)p[i + 2 * (size_t)MTOK * DM] << 16) + __uint_as_float((unsigned)p[i + 3 * (size_t)MTOK * DM] << 16) + ((const float*)(ws + WS_LNST))[i & (MTOK * 16 - 1)]; }
                if (DBG_SRC == 8) { const bf16_t* p = (const bf16_t*)(ws + WS_GA); v = __uint_as_float((unsigned)p[i] << 16) + __uint_as_float((unsigned)p[i + (size_t)MTOK * DM] << 16); }
                if (DBG_SRC == 9) { const bf16_t* p = (const bf16_t*)(ws + WS_U); v = __uint_as_float((unsigned)p[i] << 16) + __uint_as_float((unsigned)p[i + (size_t)MTOK * DM] << 16); }
                if (DBG_SRC == 4) { v = ((const float*)(ws + WS_X))[i] + ((const float*)(ws + WS_SSQ))[i & (MTOK * 8 - 1)]; }
                if (DBG_SRC == 5) { const bf16_t* p = (const bf16_t*)(ws + WS_MRG); v = __uint_as_float((unsigned)p[i] << 16); }
                if (DBG_SRC == 6) { const bf16_t* p = (const bf16_t*)(ws + WS_HID); v = __uint_as_float((unsigned)p[i] << 16) + __uint_as_float((unsigned)p[i + (size_t)MTOK * DM] << 16); }
                if (DBG_SRC == 7) { const float* p = (const float*)(ws + WS_OH); v = p[i] + p[i + (size_t)MTOK * DM]; }
                out[i] = v; } }
    } else
    if (IN(29)) {
        PH_ARGS();
        const int tid = TID_OF(wv), lane = tid & 63, wid = wv, gw = bid_ * 8 + wid, NGW = G_ * 8; (void)tid;
        const float* SSQ = (const float*)(ws + WS_SSQ); const float* X = (const float*)(ws + WS_X); const float* nf = ap->norm_final; float* out = ap->out;
        for (int m = gw; m < MTOK; m += NGW) { const float rs = row_rstd(SSQ, m);
            const f32x4* xr = (const f32x4*)(X + (size_t)m * DM) + lane; const f32x4* gr = (const f32x4*)nf + lane; f32x4* orow = (f32x4*)(out + (size_t)m * DM) + lane;
#pragma unroll
            for (int j = 0; j < 8; ++j) orow[64 * j] = xr[64 * j] * rs * gr[64 * j]; }
    }
#undef IN
#undef GRID_BAR
}

extern "C" void kernel_launch(void* const* d_in, const int* in_sizes, int n_in, void* d_out, int out_size, void* d_ws, size_t ws_size, hipStream_t stream) {
    static int grid = 0;
    if (grid == 0) {
        if (n_in != 17 || out_size != MTOK * DM || ws_size < WS_END) { fprintf(stderr, "kernel_launch: unexpected shapes (n_in %d, out %d, ws %zu < %zu); nothing launched\n", n_in, out_size, ws_size, (size_t)WS_END); grid = -1; return; }
        int dev = 0, cus = 0;
        if (hipGetDevice(&dev) != hipSuccess || hipDeviceGetAttribute(&cus, hipDeviceAttributeMultiprocessorCount, dev) != hipSuccess) { grid = -1; return; }
        if (hipFuncSetAttribute((const void*)mk_fwd, hipFuncAttributeMaxDynamicSharedMemorySize, LDS_BYTES) != hipSuccess) { fprintf(stderr, "kernel_launch: hipFuncSetAttribute failed\n"); grid = -1; return; }
        int per_cu = 0;
        if (hipOccupancyMaxActiveBlocksPerMultiprocessor(&per_cu, (const void*)mk_fwd, 512, LDS_BYTES) != hipSuccess || per_cu < 1) fprintf(stderr, "kernel_launch: occupancy query says %d\n", per_cu);
        (void)hipGetLastError();
        grid = cus;
    }
    if (grid < 0) return;
    (void)hipMemsetAsync((char*)d_ws + WS_CTL, 0, CTL_ZERO_BYTES, stream);
    Args a{};
    a.x = (const float*)d_in[0]; a.pos = (const int*)d_in[1]; a.norm_attn = (const float*)d_in[2]; a.w_in = (const float*)d_in[3]; a.gate_b = (const float*)d_in[4]; a.lam = (const float*)d_in[5];
    a.subln = (const float*)d_in[6]; a.sgu_ln_g = (const float*)d_in[7]; a.sgu_ln_b = (const float*)d_in[8]; a.w_spatial = (const float*)d_in[9]; a.b_spatial = (const float*)d_in[10];
    a.w_branch = (const float*)d_in[11]; a.w_out = (const float*)d_in[12]; a.norm_ffn = (const float*)d_in[13]; a.w_ffn_in = (const float*)d_in[14]; a.w_ffn_out = (const float*)d_in[15]; a.norm_final = (const float*)d_in[16];
    a.out = (float*)d_out; a.ws = (unsigned char*)d_ws;
#if MK_MULTI
    for (int p = 0; p < 30; ++p) { a.ph_lo = p; a.ph_hi = p + 1; hipLaunchKernelGGL(mk_fwd, dim3(grid), dim3(512), LDS_BYTES, stream, a); }
#else
    a.ph_lo = 0; a.ph_hi = 30;
    hipLaunchKernelGGL(mk_fwd, dim3(grid), dim3(512), LDS_BYTES, stream, a);
#endif
}
```

```cpp
#include <hip/hip_runtime.h>
#include <hip/hip_bf16.h>
#include <cstdio>
#include <cstdint>

#ifndef MK_MULTI
#define MK_MULTI 0
#endif

#ifndef DBG_CUT
#define DBG_CUT 0
#endif
#ifndef REP_P6_SKIPEPI
#define REP_P6_SKIPEPI 0
#endif
#ifndef ATT_ROT
#define ATT_ROT 1
#endif
#ifndef ATT_PROBE
#define ATT_PROBE 0
#endif
#ifndef LOOSE_RESTART
#define LOOSE_RESTART 1
#endif
#ifndef REP_P0
#define REP_P0 1
#endif
#ifndef REP_ATT
#define REP_ATT 1
#endif
#ifndef REP_P1
#define REP_P1 1
#endif
#ifndef REP_P3
#define REP_P3 1
#endif
#ifndef REP_P4
#define REP_P4 1
#endif
#ifndef REP_P6
#define REP_P6 1
#endif
#ifndef REP_SGU
#define REP_SGU 1
#endif
#ifndef DBG_ROT
#define DBG_ROT 0
#endif
#ifndef DBG_SRC
#define DBG_SRC 0
#endif
#ifndef EN_P0
#define EN_P0 1
#endif
#ifndef EN_P1
#define EN_P1 1
#endif
#ifndef EN_ATT
#define EN_ATT 1
#endif
#ifndef EN_SGU
#define EN_SGU 1
#endif
#ifndef EN_P3
#define EN_P3 1
#endif
#ifndef EN_P4
#define EN_P4 1
#endif
#ifndef EN_P5
#define EN_P5 1
#endif
#ifndef EN_P6
#define EN_P6 1
#endif
#ifndef EN_P7
#define EN_P7 1
#endif
#define LAS __attribute__((address_space(3)))
#define GAS __attribute__((address_space(1)))
typedef unsigned short bf16_t;
typedef short bf16x8 __attribute__((ext_vector_type(8)));
typedef short s16x4 __attribute__((ext_vector_type(4)));
typedef float f32x2 __attribute__((ext_vector_type(2)));
typedef float f32x4 __attribute__((ext_vector_type(4)));
typedef float f32x16 __attribute__((ext_vector_type(16)));
typedef unsigned u32x2 __attribute__((ext_vector_type(2)));
typedef unsigned u32x4 __attribute__((ext_vector_type(4)));

constexpr int DM = 2048, NBATCH = 4, SEQ = 4096, DEPTH = 4, MTOK = NBATCH * SEQ;
constexpr int NHEAD = 8, HDIM = 128, INCOLS = 14336, FFH = 5632, KBR = 4096;
constexpr float EPS = 1e-6f;

constexpr size_t WS_CTL = 0, CTL_ZERO_BYTES = 32768;
constexpr size_t SZ_WIN = (size_t)INCOLS * DM * 2, SZ_WBR = (size_t)DM * KBR * 2, SZ_WOUT = (size_t)DM * DM * 2, SZ_WFI = (size_t)2 * FFH * DM * 2, SZ_WFO = (size_t)DM * FFH * 2;
constexpr size_t WS_WIN = 1u << 20;
constexpr size_t WS_WBR = WS_WIN + DEPTH * SZ_WIN;
constexpr size_t WS_WOUT = WS_WBR + DEPTH * SZ_WBR;
constexpr size_t WS_WFI = WS_WOUT + DEPTH * SZ_WOUT;
constexpr size_t WS_WFO = WS_WFI + DEPTH * SZ_WFI;
constexpr size_t WS_WST = WS_WFO + DEPTH * SZ_WFO;
constexpr size_t WS_COS = WS_WST + (size_t)DEPTH * 8 * 128 * 128 * 2;
constexpr size_t WS_SIN = WS_COS + (size_t)MTOK * 64 * 2;
constexpr size_t WS_X = WS_SIN + (size_t)MTOK * 64 * 2;
constexpr size_t WS_XB = WS_X + (size_t)MTOK * DM * 4;
constexpr size_t WS_SSQ = WS_XB + (size_t)MTOK * DM * 2;
constexpr size_t WS_LNST = WS_SSQ + (size_t)MTOK * 8 * 4;
constexpr size_t WS_QH = WS_LNST + (size_t)MTOK * 16 * 4;
constexpr size_t WS_KH = WS_QH + (size_t)MTOK * DM * 2;
constexpr size_t WS_VH = WS_KH + (size_t)MTOK * DM * 2;
constexpr size_t WS_HID = WS_QH;
constexpr size_t WS_U = WS_VH + (size_t)MTOK * DM * 2;
constexpr size_t WS_MRG = WS_U;
constexpr size_t WS_GV = WS_U + (size_t)MTOK * DM * 2;
constexpr size_t WS_GA = WS_GV + (size_t)MTOK * DM * 2;
constexpr size_t WS_GS = WS_GA + (size_t)MTOK * DM * 2;
constexpr size_t WS_OH = WS_GS + (size_t)MTOK * DM * 2;
constexpr size_t WS_A2 = WS_OH + (size_t)MTOK * DM * 2 * 4;
constexpr size_t WS_END = WS_A2 + (size_t)MTOK * KBR * 2;
static_assert((size_t)MTOK * FFH * 2 <= 3 * (size_t)MTOK * DM * 2, "hidden overlays q|k|v");
constexpr int CW_BAR = 4096;

constexpr int RING_BYTES = 131072;
constexpr int XS_OFF = RING_BYTES;
constexpr int RS_OFF = XS_OFF + 8192;
constexpr int MISC_OFF = RS_OFF + 1024;
constexpr int LDS_BYTES = 147456;

typedef __bf16 bf16x2_t __attribute__((ext_vector_type(2)));
__device__ __forceinline__ unsigned cvt_pk_bf16(float lo, float hi) { f32x2 v = {lo, hi}; bf16x2_t b = __builtin_convertvector(v, bf16x2_t); return __builtin_bit_cast(unsigned, b); }
__device__ __forceinline__ float bf_lo(unsigned w) { return __uint_as_float(w << 16); }
__device__ __forceinline__ float bf_hi(unsigned w) { return __uint_as_float(w & 0xffff0000u); }
__device__ __forceinline__ int lane_id() { int r; asm volatile("v_mbcnt_lo_u32_b32 %0, -1, 0\n\tv_mbcnt_hi_u32_b32 %0, -1, %0" : "=v"(r)); return r; }
#define TID_OF(wv) (((wv) << 6) | lane_id())
__device__ __forceinline__ float wave_sum(float v, int lane) {
#pragma unroll
    for (int o = 1; o < 64; o <<= 1) v += __uint_as_float((unsigned)__builtin_amdgcn_ds_bpermute((lane ^ o) << 2, (int)__float_as_uint(v)));
    return v;
}
__device__ __forceinline__ float sum_x16_x32(float v) {
    { auto r = __builtin_amdgcn_permlane16_swap(__float_as_uint(v), __float_as_uint(v), false, false); v = __uint_as_float(r[0]) + __uint_as_float(r[1]); }
    { auto r = __builtin_amdgcn_permlane32_swap(__float_as_uint(v), __float_as_uint(v), false, false); v = __uint_as_float(r[0]) + __uint_as_float(r[1]); }
    return v;
}
__device__ __forceinline__ float sigmoidf_(float x) { return __builtin_amdgcn_rcpf(1.0f + __builtin_amdgcn_exp2f(-1.4426950408889634f * x)); }
__device__ __forceinline__ f32x2 gelu_pk(f32x2 v) {
    const f32x2 av = __builtin_elementwise_abs(v), d = av * 0.2316418882f + 1.0f;
    f32x2 t; t.x = __builtin_amdgcn_rcpf(d.x); t.y = __builtin_amdgcn_rcpf(d.y);
    f32x2 q = t * 0.5307027145f + (-0.7265760135f); q = q * t + 0.7107068705f; q = q * t + (-0.142248368f); q = q * t + 0.127414796f; q = q * t;
    const f32x2 s = (v * v) * (-0.72134752044f);
    f32x2 e; e.x = __builtin_amdgcn_exp2f(s.x); e.y = __builtin_amdgcn_exp2f(s.y);
    const f32x2 m = v * (q * e), r = v - m;
    f32x2 o; o.x = v.x < 0.f ? m.x : r.x; o.y = v.y < 0.f ? m.y : r.y; return o;
}
__device__ __forceinline__ f32x4 gelu4(f32x4 v) { const f32x2 a = gelu_pk((f32x2){v[0], v[1]}), b = gelu_pk((f32x2){v[2], v[3]}); return (f32x4){a.x, a.y, b.x, b.y}; }
__device__ __forceinline__ void gelu8(f32x4 (&g)[2], f32x2& s1, f32x2& s2) {
    f32x2 v[4], t[4], q[4], e[4];
#pragma unroll
    for (int i = 0; i < 4; ++i) v[i] = (f32x2){g[i >> 1][(i & 1) * 2], g[i >> 1][(i & 1) * 2 + 1]};
#pragma unroll
    for (int i = 0; i < 4; ++i) { const f32x2 d = __builtin_elementwise_abs(v[i]) * 0.2316418882f + 1.0f; t[i].x = __builtin_amdgcn_rcpf(d.x); t[i].y = __builtin_amdgcn_rcpf(d.y); }
    __builtin_amdgcn_sched_barrier(0);
#pragma unroll
    for (int i = 0; i < 4; ++i) { const f32x2 s = (v[i] * v[i]) * (-0.72134752044f); e[i].x = __builtin_amdgcn_exp2f(s.x); e[i].y = __builtin_amdgcn_exp2f(s.y); }
    __builtin_amdgcn_sched_barrier(0);
#pragma unroll
    for (int i = 0; i < 4; ++i) q[i] = t[i] * 0.5307027145f + (-0.7265760135f);
    __builtin_amdgcn_sched_barrier(0);
#pragma unroll
    for (int i = 0; i < 4; ++i) q[i] = q[i] * t[i] + 0.7107068705f;
    __builtin_amdgcn_sched_barrier(0);
#pragma unroll
    for (int i = 0; i < 4; ++i) q[i] = q[i] * t[i] + (-0.142248368f);
    __builtin_amdgcn_sched_barrier(0);
#pragma unroll
    for (int i = 0; i < 4; ++i) q[i] = q[i] * t[i] + 0.127414796f;
    __builtin_amdgcn_sched_barrier(0);
#pragma unroll
    for (int i = 0; i < 4; ++i) q[i] = (q[i] * t[i]) * e[i];
    __builtin_amdgcn_sched_barrier(0);
#pragma unroll
    for (int i = 0; i < 4; ++i) { f32x2 mx; mx.x = fmaxf(v[i].x, 0.f); mx.y = fmaxf(v[i].y, 0.f); const f32x2 o = mx - __builtin_elementwise_abs(v[i]) * q[i];
        s1 += o; s2 += o * o; g[i >> 1][(i & 1) * 2] = o.x; g[i >> 1][(i & 1) * 2 + 1] = o.y; }
}
__device__ __forceinline__ u32x4 pack8(f32x4 a, f32x4 b) { u32x4 w; w.x = cvt_pk_bf16(a[0], a[1]); w.y = cvt_pk_bf16(a[2], a[3]); w.z = cvt_pk_bf16(b[0], b[1]); w.w = cvt_pk_bf16(b[2], b[3]); return w; }

namespace pg8 {
constexpr int BM = 256, BK = 64, HALF = 128, HTB = HALF * BK * 2, STAGE_BYTES = 8 * HTB, NXCD = 8, WGM = 8;
__host__ __device__ __forceinline__ int lds_byte(int r, int c) { const int st = (r >> 4) * 2 + (c >> 5), rr = r & 15, cc = c & 31, ob = rr * 64 + cc * 2; return st * 1024 + (ob ^ (((ob >> 9) & 1) << 5)); }
__host__ __device__ __forceinline__ void stage_rc(int b, int& R, int& C) { const int st = b / 1024, sb = b % 1024, swz = sb ^ (((sb >> 9) & 1) << 5); R = (st >> 1) * 16 + swz / 64; C = (st & 1) * 32 + (swz % 64) / 2; }
__host__ __device__ __forceinline__ int perm32(int rho) { const int n = rho >> 4, i = rho & 15; return 8 * (i >> 2) + 4 * n + (i & 3); }
struct Unit { int pm, pn; };
struct Gemm { const bf16_t* A; const bf16_t* Bt; int M, N, K; };
struct StaticOrder {
    int nM, nN, nwg, G, c, rot;
    __host__ __device__ void init(int M, int N, int G_, int c_, int rot_ = 0) { nM = M / BM; nN = N / BM; nwg = nM * nN; G = G_; c = c_; rot = rot_; }
    __host__ __device__ bool next(int i, Unit& u) const {
        if (G == 256 && nM == 64 && rot == 0 && (nN & 3) == 0) { const int pn = 4 * i + (c >> 6); if (pn >= nN) return false; u.pm = 8 * (c & 7) + ((c >> 3) & 7); u.pn = pn; return true; }
        const long L = (long)i * G + c; if (L >= nwg) return false;
        int wgid = (int)L; { const int q = nwg / NXCD, r = nwg % NXCD, xcd = wgid % NXCD, off = wgid / NXCD; wgid = (xcd < r ? xcd * (q + 1) : r * (q + 1) + (xcd - r) * q) + off; }
        const int nig = WGM * nN, gid = wgid / nig, fm = gid * WGM, gsz = (nM - fm) < WGM ? (nM - fm) : WGM;
        u.pm = fm + ((wgid % nig) % gsz); u.pn = ((wgid % nig) / gsz + rot) % nN; return true;
    }
};
template <class Epi>
__device__ __forceinline__ void gemm_phase(LAS unsigned char* lds, const Gemm g, const StaticOrder& S, const Epi& E, const int wv) {
    int tid_ = TID_OF(wv); asm volatile("" : "+v"(tid_));
    const int tid = tid_, wid = __builtin_amdgcn_readfirstlane(tid >> 6), lane = tid & 63, wr = wid >> 2, wc = wid & 3, fr = lane & 15, fq = lane >> 4;
    const int K = g.K, nt = K / BK;
    unsigned voffA[2], voffB[2];
#pragma unroll
    for (int i = 0; i < 2; ++i) { int R, C; stage_rc(tid * 16 + i * 8192, R, C); const int Rb = (R & ~31) + perm32(R & 31);
        voffA[i] = (unsigned)(R * K + C) * 2u; voffB[i] = (unsigned)(Rb * K + C) * 2u; }
    const size_t kstep = (size_t)(BK * 2);
    const size_t hstep = (size_t)HALF * K * 2;
    const size_t tstep = 2 * hstep;
    const unsigned ldsw = (unsigned)wid * 1024u;
    const int aoff = lds_byte(wr * 64 + fr, fq * 8), boff = lds_byte(wc * 32 + fr, fq * 8);
#define PG8_SA(b, h) (((b) * 2 + (h)) * HTB)
#define PG8_SB(b, h) ((4 + (b) * 2 + (h)) * HTB)
#define PG8_STAGE(bufoff, gbase, voff) do { _Pragma("unroll") for (int _i = 0; _i < 2; ++_i) { unsigned _vo = (voff)[_i]; asm volatile("" : "+v"(_vo)); \
        __builtin_amdgcn_global_load_lds((const unsigned*)((const char*)(gbase) + _vo), (LAS unsigned*)(lds + (bufoff) + ldsw + _i * 8192), 16, 0, 0); } } while (0)
#define PG8_LDA(dst, b, h) do { _Pragma("unroll") for (int m = 0; m < 4; ++m) _Pragma("unroll") for (int k = 0; k < 2; ++k) dst[m][k] = *(const LAS bf16x8*)(lds + PG8_SA(b, h) + aoff + m * 2048 + k * 1024); } while (0)
#define PG8_LDB(dst, b, h) do { _Pragma("unroll") for (int n = 0; n < 2; ++n) _Pragma("unroll") for (int k = 0; k < 2; ++k) dst[n][k] = *(const LAS bf16x8*)(lds + PG8_SB(b, h) + boff + n * 2048 + k * 1024); } while (0)
#define PG8_MMA(ai, bj, At, Bt) do { __builtin_amdgcn_s_setprio(1); _Pragma("unroll") for (int m = 0; m < 4; ++m) _Pragma("unroll") for (int n = 0; n < 2; ++n) _Pragma("unroll") for (int k = 0; k < 2; ++k) \
        acc[ai][bj][m][n] = __builtin_amdgcn_mfma_f32_16x16x32_bf16(Bt[n][k], At[m][k], acc[ai][bj][m][n], 0, 0, 0); __builtin_amdgcn_s_setprio(0); } while (0)
#define PG8_MMA0(ai, bj, At, Bt) do { __builtin_amdgcn_s_setprio(1); _Pragma("unroll") for (int m = 0; m < 4; ++m) _Pragma("unroll") for (int n = 0; n < 2; ++n) { \
        acc[ai][bj][m][n] = __builtin_amdgcn_mfma_f32_16x16x32_bf16(Bt[n][0], At[m][0], (f32x4){0.f, 0.f, 0.f, 0.f}, 0, 0, 0); \
        acc[ai][bj][m][n] = __builtin_amdgcn_mfma_f32_16x16x32_bf16(Bt[n][1], At[m][1], acc[ai][bj][m][n], 0, 0, 0); } __builtin_amdgcn_s_setprio(0); } while (0)
#define PG8_WAIT_V(n) asm volatile("s_waitcnt vmcnt(" #n ")" ::: "memory")
#define PG8_WAIT_L(n) asm volatile("s_waitcnt lgkmcnt(" #n ")" ::: "memory")
#define PG8_BAR __builtin_amdgcn_s_barrier()
#define PG8_SCHED __builtin_amdgcn_sched_barrier(0)
    Unit cur, nxt; int ui = 0;
    if (!S.next(0, cur)) return;
    f32x4 acc[2][2][4][2];
    bf16x8 At[4][2], B0[2][2], B1[2][2];
    const char* cA = (const char*)g.A + (size_t)cur.pm * tstep; const char* cB = (const char*)g.Bt + (size_t)cur.pn * tstep;
    PG8_STAGE(PG8_SB(0, 0), cB, voffB); PG8_STAGE(PG8_SB(0, 1), cB + hstep, voffB); PG8_STAGE(PG8_SA(0, 0), cA, voffA); PG8_STAGE(PG8_SA(0, 1), cA + hstep, voffA);
    if (wr == 1) PG8_BAR;
    PG8_WAIT_V(2); PG8_BAR;
    PG8_STAGE(PG8_SB(1, 0), cB + kstep, voffB); PG8_STAGE(PG8_SA(1, 0), cA + kstep, voffA); PG8_STAGE(PG8_SB(1, 1), cB + hstep + kstep, voffB);
    PG8_WAIT_V(6); PG8_BAR;
    for (;;) {
        const bool has_next = S.next(ui + 1, nxt);
        const char* nA = has_next ? (const char*)g.A + (size_t)nxt.pm * tstep : cA; const char* nB = has_next ? (const char*)g.Bt + (size_t)nxt.pn * tstep : cB;
#define K_BODY(t, MMAF, MIDCHK, W12) do { \
            if constexpr (Epi::MID && MIDCHK) { if ((t) == (nt >> 1)) E.mid(acc, cur, wr, wc, fr, fq); } \
            const bool last = ((t) == nt - 2); \
            const char* a1 = cA + (size_t)((t) + 1) * kstep; \
            const char* a2 = last ? nA : cA + (size_t)((t) + 2) * kstep; const char* b2 = last ? nB : cB + (size_t)((t) + 2) * kstep; \
            const char* a3 = a2 + kstep; const char* b3 = b2 + kstep; \
            PG8_LDB(B0, 0, 0); PG8_LDB(B1, 0, 1); PG8_SCHED; PG8_LDA(At, 0, 0); PG8_STAGE(PG8_SA(1, 1), a1 + hstep, voffA); \
            W12; PG8_WAIT_L(0); PG8_BAR; MMAF(0, 0, At, B0); MMAF(0, 1, At, B1); PG8_BAR; PG8_SCHED; \
            PG8_LDA(At, 0, 1); PG8_STAGE(PG8_SB(0, 0), b2, voffB); PG8_STAGE(PG8_SB(0, 1), b2 + hstep, voffB); PG8_STAGE(PG8_SA(0, 0), a2, voffA); \
            W12; PG8_WAIT_L(0); PG8_BAR; MMAF(1, 0, At, B0); MMAF(1, 1, At, B1); PG8_BAR; PG8_SCHED; \
            PG8_LDB(B0, 1, 0); PG8_LDB(B1, 1, 1); PG8_SCHED; PG8_LDA(At, 1, 0); PG8_STAGE(PG8_SA(0, 1), a2 + hstep, voffA); \
            PG8_WAIT_V(8); PG8_WAIT_L(0); PG8_BAR; PG8_MMA(0, 0, At, B0); PG8_MMA(0, 1, At, B1); PG8_BAR; PG8_SCHED; \
            PG8_LDA(At, 1, 1); PG8_STAGE(PG8_SB(1, 0), b3, voffB); PG8_STAGE(PG8_SB(1, 1), b3 + hstep, voffB); PG8_STAGE(PG8_SA(1, 0), a3, voffA); \
            PG8_WAIT_V(8); PG8_WAIT_L(0); PG8_BAR; PG8_MMA(1, 0, At, B0); PG8_MMA(1, 1, At, B1); PG8_BAR; PG8_SCHED; \
        } while (0)
#define PG8_WAIT_FIRST() do { if (LOOSE_RESTART && ui > 0) { if constexpr (Epi::NVM >= 32) asm volatile("s_waitcnt vmcnt(40)" ::: "memory"); else if constexpr (Epi::NVM >= 16) asm volatile("s_waitcnt vmcnt(24)" ::: "memory"); \
            else if constexpr (Epi::NVM >= 8) asm volatile("s_waitcnt vmcnt(16)" ::: "memory"); else asm volatile("s_waitcnt vmcnt(8)" ::: "memory"); } else asm volatile("s_waitcnt vmcnt(8)" ::: "memory"); } while (0)
        K_BODY(0, PG8_MMA0, false, PG8_WAIT_FIRST());
        for (int t = 2; t < nt; t += 2) K_BODY(t, PG8_MMA, true, PG8_WAIT_V(8));
#undef PG8_WAIT_FIRST
#undef K_BODY
        if (wr == 0) PG8_BAR;
        { const int lane_ = lane_id();
          E(acc, cur, wr, wc, lane_ & 15, lane_ >> 4); }
        if (!has_next) break;
        cur = nxt; cA = nA; cB = nB; ++ui;
        if (wr == 1) PG8_BAR;
    }
    PG8_WAIT_V(0);
    PG8_BAR;
#undef PG8_SA
#undef PG8_SB
#undef PG8_STAGE
#undef PG8_LDA
#undef PG8_LDB
#undef PG8_MMA
#undef PG8_WAIT_V
#undef PG8_WAIT_L
#undef PG8_BAR
#undef PG8_SCHED
}
}

struct Args {
    const float* x; const int* pos; const float* norm_attn; const float* w_in; const float* gate_b; const float* lam; const float* subln; const float* sgu_ln_g; const float* sgu_ln_b;
    const float* w_spatial; const float* b_spatial; const float* w_branch; const float* w_out; const float* norm_ffn; const float* w_ffn_in; const float* w_ffn_out; const float* norm_final;
    float* out; unsigned char* ws; int ph_lo, ph_hi;
};

typedef const __attribute__((address_space(4))) Args* ArgP;
__device__ __forceinline__ ArgP get_args() { ArgP p = (ArgP)__builtin_amdgcn_kernarg_segment_ptr(); asm volatile("" : "+s"(p)); return p; }
template <class T> __device__ __forceinline__ T* as_global(T* p) { return (T*)(GAS T*)p; }
__device__ __forceinline__ unsigned char* launder(unsigned char* p) { asm volatile("" : "+s"(p)); return as_global(p); }
extern __shared__ __attribute__((aligned(16))) unsigned char lds_raw[];
__device__ __forceinline__ LAS unsigned char* lds_base() { return (LAS unsigned char*)lds_raw; }

typedef f32x4 AccT[2][2][4][2];
#define EPI_BAR() do { asm volatile("s_waitcnt lgkmcnt(0)" ::: "memory"); __builtin_amdgcn_s_barrier(); asm volatile("" ::: "memory"); } while (0)
typedef _Float16 h16x2 __attribute__((ext_vector_type(2)));
__device__ __forceinline__ float row_rstd(const float* ssq, int row) {
    const f32x4 a = *(const f32x4*)(ssq + (size_t)row * 8), b = *(const f32x4*)(ssq + (size_t)row * 8 + 4);
    const float s = ((a[0] + a[1]) + (a[2] + a[3])) + ((b[0] + b[1]) + (b[2] + b[3]));
    return __builtin_amdgcn_rsqf(s * (1.0f / DM) + EPS);
}
__device__ __forceinline__ void panel_rstd_to_lds(const float* ssq, int pm, int tid) { if (tid < 256) ((LAS float*)(lds_base() + RS_OFF))[tid] = row_rstd(ssq, pm * 256 + tid); }
__device__ __forceinline__ void load_rstd(float (&rs)[8], const float* ssq, int pm, int pm0, int rl0) {
    const LAS float* rsl = (const LAS float*)(lds_base() + RS_OFF);
#pragma unroll
    for (int i = 0; i < 8; ++i) { const int rl = rl0 + (i >> 2) * 128 + (i & 3) * 16; rs[i] = (pm == pm0) ? rsl[rl] : row_rstd(ssq, pm * 256 + rl); }
}

struct EpiIn {
    static constexpr bool MID = false; static constexpr int NVM = 16;
    int l, pm0;
    __device__ __forceinline__ void operator()(const AccT& acc, const pg8::Unit& u, int wr, int wc, int fr, int fq) const {
        unsigned char* ws = get_args()->ws;
        const int pn = u.pn, rl0 = wr * 64 + fr, rowu = u.pm * 256 + wr * 64;
        float rs[8]; load_rstd(rs, (const float*)(ws + WS_SSQ), u.pm, pm0, rl0);
        if (pn < 16) {
            bf16_t* dst = (bf16_t*)(ws + (pn < 8 ? WS_QH : WS_KH)); const int h = pn & 7, c = wc >> 1; const unsigned d0 = 32 * (wc & 1) + 8 * fq;
            const _Float16* cosT = (const _Float16*)(ws + WS_COS) + (size_t)rowu * 64; const _Float16* sinT = (const _Float16*)(ws + WS_SIN) + (size_t)rowu * 64;
            const unsigned lt = (unsigned)fr * 64u + d0;
            const int bb = rowu >> 12, su = rowu & 4095;
            bf16_t* dsth = dst + ((size_t)(((bb * NHEAD + h) * 2 + c) * SEQ + su)) * HDIM; const unsigned lo = (unsigned)fr * HDIM + d0;
#pragma unroll
            for (int ai = 0; ai < 2; ++ai) {
                u32x4 cw[4], sw[4];
#pragma unroll
                for (int m = 0; m < 4; ++m) { const int ro = (ai * 128 + m * 16) * 64; cw[m] = *(const u32x4*)(cosT + ro + lt); sw[m] = *(const u32x4*)(sinT + ro + lt); }
#pragma unroll
                for (int m = 0; m < 4; ++m) {
                    const float r = rs[ai * 4 + m];
                    f32x4 c0, c1, s0, s1;
#pragma unroll
                    for (int q = 0; q < 2; ++q) { const unsigned wca = cw[m][q], wcb = cw[m][q + 2], wsa = sw[m][q], wsb = sw[m][q + 2];
                        const h16x2 ca = __builtin_bit_cast(h16x2, wca), cb = __builtin_bit_cast(h16x2, wcb), sa = __builtin_bit_cast(h16x2, wsa), sb = __builtin_bit_cast(h16x2, wsb);
                        c0[2 * q] = (float)ca[0]; c0[2 * q + 1] = (float)ca[1]; c1[2 * q] = (float)cb[0]; c1[2 * q + 1] = (float)cb[1];
                        s0[2 * q] = (float)sa[0]; s0[2 * q + 1] = (float)sa[1]; s1[2 * q] = (float)sb[0]; s1[2 * q + 1] = (float)sb[1]; }
                    const f32x4 l0 = acc[ai][0][m][0] * r, l1 = acc[ai][0][m][1] * r, h0 = acc[ai][1][m][0] * r, h1 = acc[ai][1][m][1] * r;
                    const f32x4 ol0 = l0 * c0 - h0 * s0, ol1 = l1 * c1 - h1 * s1, oh0 = h0 * c0 + l0 * s0, oh1 = h1 * c1 + l1 * s1;
                    bf16_t* p = dsth + (ai * 128 + m * 16) * HDIM;
                    *(u32x4*)(p + lo) = pack8(ol0, ol1); *(u32x4*)(p + 64 + lo) = pack8(oh0, oh1);
                } }
        } else if (pn < 24) {
            const int h = pn - 16, bb = rowu >> 12, su = rowu & 4095; const unsigned lo = (unsigned)fr * HDIM + 32 * wc + 8 * fq;
#pragma unroll
            for (int bj = 0; bj < 2; ++bj) { bf16_t* vb = (bf16_t*)(ws + WS_VH) + ((size_t)(((bb * NHEAD + h) * 2 + bj) * SEQ + su)) * HDIM;
#pragma unroll
                for (int ai = 0; ai < 2; ++ai)
#pragma unroll
                    for (int m = 0; m < 4; ++m) { const float r = rs[ai * 4 + m]; *(u32x4*)(vb + (ai * 128 + m * 16) * HDIM + lo) = pack8(acc[ai][bj][m][0] * r, acc[ai][bj][m][1] * r); } }
        } else if (pn < 32) {
            bf16_t* dst = (bf16_t*)(ws + WS_U) + (size_t)rowu * DM + 256 * (pn - 24); const unsigned lo = (unsigned)fr * DM + 32 * wc + 8 * fq;
#pragma unroll
            for (int ai = 0; ai < 2; ++ai)
#pragma unroll
                for (int m = 0; m < 4; ++m) { const float r = rs[ai * 4 + m];
#pragma unroll
                    for (int bj = 0; bj < 2; ++bj) *(u32x4*)(dst + (ai * 128 + m * 16) * DM + bj * 128 + lo) = pack8(acc[ai][bj][m][0] * r, acc[ai][bj][m][1] * r); }
        } else if (pn < 40) {
            bf16_t* dst = (bf16_t*)(ws + WS_GV) + (size_t)rowu * DM + 256 * (pn - 32); const unsigned lo = (unsigned)fr * DM + 32 * wc + 8 * fq;
            LAS f32x2* xs = (LAS f32x2*)(lds_base() + XS_OFF);
#pragma unroll
            for (int ai = 0; ai < 2; ++ai)
#pragma unroll
                for (int m = 0; m < 4; ++m) {
                    const float r = rs[ai * 4 + m];
                    f32x2 a1 = {0.f, 0.f}, a2 = {0.f, 0.f};
#pragma unroll
                    for (int bj = 0; bj < 2; ++bj) { f32x4 g[2] = {acc[ai][bj][m][0] * r, acc[ai][bj][m][1] * r};
                        gelu8(g, a1, a2);
                        *(u32x4*)(dst + (ai * 128 + m * 16) * DM + bj * 128 + lo) = pack8(g[0], g[1]); }
                    const float s1 = sum_x16_x32(a1.x + a1.y), s2 = sum_x16_x32(a2.x + a2.y);
                    if (fq == 0) xs[(rl0 + ai * 128 + m * 16) * 4 + wc] = (f32x2){s1, s2};
                }
            EPI_BAR();
            { float* lnst = (float*)(ws + WS_LNST);
                const int t = 64 * (4 * wr + wc) + lane_id();
                if (t < 256) { const f32x2 a = xs[t * 4 + 0], b = xs[t * 4 + 1], c = xs[t * 4 + 2], d = xs[t * 4 + 3];
                    *(f32x2*)(lnst + (size_t)(u.pm * 256 + t) * 16 + 2 * (pn - 32)) = (f32x2){(a.x + b.x) + (c.x + d.x), (a.y + b.y) + (c.y + d.y)}; } }
            EPI_BAR();
        } else {
            const int ch0 = 128 * (pn - 40); bf16_t* dR = (bf16_t*)(ws + WS_GA) + (size_t)rowu * DM + ch0; bf16_t* dS = (bf16_t*)(ws + WS_GS) + (size_t)rowu * DM + ch0; const unsigned lo = (unsigned)fr * DM + 32 * wc + 8 * fq;
            const float* gb = get_args()->gate_b + l * 2 * DM + ch0; const unsigned lc = 32 * wc + 8 * fq;
            f32x4 bv[2][2];
#pragma unroll
            for (int bj = 0; bj < 2; ++bj)
#pragma unroll
                for (int n = 0; n < 2; ++n) bv[bj][n] = *(const f32x4*)(gb + bj * DM + 4 * n + lc) * (-1.4426950408889634f);
#pragma unroll
            for (int ai = 0; ai < 2; ++ai)
#pragma unroll
                for (int m = 0; m < 4; ++m) {
                    const float r = rs[ai * 4 + m] * (-1.4426950408889634f);
                    f32x4 rr[2], gg[2];
#pragma unroll
                    for (int n = 0; n < 2; ++n) { const f32x4 xa = acc[ai][0][m][n] * r + bv[0][n], xs_ = acc[ai][1][m][n] * r + bv[1][n];
#pragma unroll
                        for (int h = 0; h < 2; ++h) { f32x2 ea, ds;
                            ea.x = __builtin_amdgcn_exp2f(xa[2 * h]); ea.y = __builtin_amdgcn_exp2f(xa[2 * h + 1]);
                            ds.x = __builtin_amdgcn_exp2f(fminf(xs_[2 * h], 100.f)); ds.y = __builtin_amdgcn_exp2f(fminf(xs_[2 * h + 1], 100.f));
                            ea = ea + 1.0f; ds = ds + 1.0f;
                            f32x2 ra, rd; ra.x = __builtin_amdgcn_rcpf(ea.x); ra.y = __builtin_amdgcn_rcpf(ea.y); rd.x = __builtin_amdgcn_rcpf(ds.x); rd.y = __builtin_amdgcn_rcpf(ds.y);
                            const f32x2 rt = ds * ra; gg[n][2 * h] = rd.x; gg[n][2 * h + 1] = rd.y; rr[n][2 * h] = rt.x; rr[n][2 * h + 1] = rt.y; } }
                    *(u32x4*)(dR + (ai * 128 + m * 16) * DM + lo) = pack8(rr[0], rr[1]); *(u32x4*)(dS + (ai * 128 + m * 16) * DM + lo) = pack8(gg[0], gg[1]);
                }
        }
    }
};

struct EpiBranch {
    static constexpr bool MID = true; static constexpr int NVM = 32;
    __device__ __forceinline__ void mid(AccT& acc, const pg8::Unit& u, int wr, int wc, int fr, int fq) const {
        unsigned char* ws = get_args()->ws; const size_t uo = (size_t)(u.pm * 256 + wr * 64) * DM + u.pn * 256; const unsigned lo = (unsigned)fr * DM + 32 * wc + 8 * fq;
        const bf16_t* GA = (const bf16_t*)(ws + WS_GA) + uo;
        u32x4 ga[2][4][2];
#pragma unroll
        for (int ai = 0; ai < 2; ++ai)
#pragma unroll
            for (int m = 0; m < 4; ++m)
#pragma unroll
                for (int bj = 0; bj < 2; ++bj) ga[ai][m][bj] = *(const u32x4*)(GA + (ai * 128 + m * 16) * DM + bj * 128 + lo);
#pragma unroll
        for (int ai = 0; ai < 2; ++ai)
#pragma unroll
            for (int m = 0; m < 4; ++m)
#pragma unroll
                for (int bj = 0; bj < 2; ++bj)
#pragma unroll
                    for (int q = 0; q < 4; ++q) { acc[ai][bj][m][q >> 1][(q & 1) * 2] *= bf_lo(ga[ai][m][bj][q]); acc[ai][bj][m][q >> 1][(q & 1) * 2 + 1] *= bf_hi(ga[ai][m][bj][q]); }
        asm volatile("" ::: "memory");
    }
    __device__ __forceinline__ void operator()(const AccT& acc, const pg8::Unit& u, int wr, int wc, int fr, int fq) const {
        unsigned char* ws = get_args()->ws; const size_t uo = (size_t)(u.pm * 256 + wr * 64) * DM + u.pn * 256; const unsigned lo = (unsigned)fr * DM + 32 * wc + 8 * fq;
        const bf16_t* GS = (const bf16_t*)(ws + WS_GS) + uo; bf16_t* MRG = (bf16_t*)(ws + WS_MRG) + uo;
#pragma unroll
        for (int ai = 0; ai < 2; ++ai) {
            u32x4 gs[4][2];
#pragma unroll
            for (int m = 0; m < 4; ++m)
#pragma unroll
                for (int bj = 0; bj < 2; ++bj) gs[m][bj] = *(const u32x4*)(GS + (ai * 128 + m * 16) * DM + bj * 128 + lo);
#pragma unroll
            for (int m = 0; m < 4; ++m)
#pragma unroll
                for (int bj = 0; bj < 2; ++bj) { const u32x4 s = gs[m][bj]; f32x4 v0 = acc[ai][bj][m][0], v1 = acc[ai][bj][m][1];
                    v0[0] *= fmaxf(bf_lo(s[0]), 1e-30f); v0[1] *= fmaxf(bf_hi(s[0]), 1e-30f); v0[2] *= fmaxf(bf_lo(s[1]), 1e-30f); v0[3] *= fmaxf(bf_hi(s[1]), 1e-30f);
                    v1[0] *= fmaxf(bf_lo(s[2]), 1e-30f); v1[1] *= fmaxf(bf_hi(s[2]), 1e-30f); v1[2] *= fmaxf(bf_lo(s[3]), 1e-30f); v1[3] *= fmaxf(bf_hi(s[3]), 1e-30f);
                    *(u32x4*)(MRG + (ai * 128 + m * 16) * DM + bj * 128 + lo) = pack8(v0, v1); } }
    }
};

struct EpiResid {
    static constexpr bool MID = false; static constexpr int NVM = 32;
    int first, last;
    __device__ __forceinline__ void operator()(const AccT& acc, const pg8::Unit& u, int wr, int wc, int fr, int fq) const {
        unsigned char* ws = get_args()->ws; const size_t uo = (size_t)(u.pm * 256 + wr * 64) * DM + u.pn * 256; const unsigned lo = (unsigned)fr * DM + 32 * wc + 8 * fq;
        float* X = (float*)(ws + WS_X) + uo; bf16_t* XB = (bf16_t*)(ws + WS_XB) + uo; float* ssq = (float*)(ws + WS_SSQ); LAS f32x2* xs = (LAS f32x2*)(lds_base() + XS_OFF);
        const float* base = get_args()->x + uo;
        const int rl0 = wr * 64 + fr;
#pragma unroll
        for (int ai = 0; ai < 2; ++ai) {
            f32x4 bs[4][2][2];
            if (first) {
#pragma unroll
                for (int m = 0; m < 4; ++m)
#pragma unroll
                    for (int bj = 0; bj < 2; ++bj) { const int ro = (ai * 128 + m * 16) * DM + bj * 128; bs[m][bj][0] = *(const f32x4*)(base + ro + lo); bs[m][bj][1] = *(const f32x4*)(base + ro + 4 + lo); }
            } else {
                u32x4 bb[4][2];
#pragma unroll
                for (int m = 0; m < 4; ++m)
#pragma unroll
                    for (int bj = 0; bj < 2; ++bj) bb[m][bj] = *(const u32x4*)(XB + (ai * 128 + m * 16) * DM + bj * 128 + lo);
#pragma unroll
                for (int m = 0; m < 4; ++m)
#pragma unroll
                    for (int bj = 0; bj < 2; ++bj) { const u32x4 b = bb[m][bj];
                        bs[m][bj][0] = (f32x4){bf_lo(b[0]), bf_hi(b[0]), bf_lo(b[1]), bf_hi(b[1])}; bs[m][bj][1] = (f32x4){bf_lo(b[2]), bf_hi(b[2]), bf_lo(b[3]), bf_hi(b[3])}; }
            }
#pragma unroll
            for (int m = 0; m < 4; ++m) { float s2 = 0.f;
#pragma unroll
                for (int bj = 0; bj < 2; ++bj) { const int ro = (ai * 128 + m * 16) * DM + bj * 128;
                    const f32x4 v0 = bs[m][bj][0] + acc[ai][bj][m][0], v1 = bs[m][bj][1] + acc[ai][bj][m][1];
                    if (last) { *(f32x4*)(X + ro + lo) = v0; *(f32x4*)(X + ro + 4 + lo) = v1; }
                    else *(u32x4*)(XB + ro + lo) = pack8(v0, v1);
                    s2 += ((v0[0] * v0[0] + v0[1] * v0[1]) + (v0[2] * v0[2] + v0[3] * v0[3])) + ((v1[0] * v1[0] + v1[1] * v1[1]) + (v1[2] * v1[2] + v1[3] * v1[3])); }
                s2 = sum_x16_x32(s2);
                if (fq == 0) xs[(rl0 + ai * 128 + m * 16) * 4 + wc] = (f32x2){s2, 0.f}; } }
        EPI_BAR();
        const int t = 64 * (4 * wr + wc) + lane_id();
        if (t < 256) { const f32x2 a = xs[t * 4 + 0], b = xs[t * 4 + 1], c = xs[t * 4 + 2], d = xs[t * 4 + 3]; ssq[(size_t)(u.pm * 256 + t) * 8 + u.pn] = (a.x + b.x) + (c.x + d.x); }
        EPI_BAR();
    }
};

struct EpiSwiglu {
    static constexpr bool MID = false; static constexpr int NVM = REP_P6_SKIPEPI ? 0 : 8;
    int pm0, skip;
    __device__ __forceinline__ void operator()(const AccT& acc, const pg8::Unit& u, int wr, int wc, int fr, int fq) const {
        if (skip) { if (acc[0][0][0][0][0] == 12345.678f) *(volatile float*)(get_args()->ws + WS_OH) = 1.f; return; }
        unsigned char* ws = get_args()->ws; bf16_t* HID = (bf16_t*)(ws + WS_HID) + (size_t)(u.pm * 256 + wr * 64) * FFH + u.pn * 128; const unsigned lo = (unsigned)fr * FFH + 32 * wc + 8 * fq;
        const int rl0 = wr * 64 + fr;
        float rs[8]; load_rstd(rs, (const float*)(ws + WS_SSQ), u.pm, pm0, rl0);
#pragma unroll
        for (int ai = 0; ai < 2; ++ai)
#pragma unroll
            for (int m = 0; m < 4; ++m) { const float r = rs[ai * 4 + m], rn = r * (-1.4426950408889634f), r2 = r * r;
                f32x2 a2[4], b2[4], den[4], rc[4], ab[4];
#pragma unroll
                for (int i = 0; i < 4; ++i) { a2[i] = (f32x2){acc[ai][0][m][i >> 1][(i & 1) * 2], acc[ai][0][m][i >> 1][(i & 1) * 2 + 1]}; b2[i] = (f32x2){acc[ai][1][m][i >> 1][(i & 1) * 2], acc[ai][1][m][i >> 1][(i & 1) * 2 + 1]}; }
#pragma unroll
                for (int i = 0; i < 4; ++i) { const f32x2 t = a2[i] * rn; den[i].x = __builtin_amdgcn_exp2f(t.x); den[i].y = __builtin_amdgcn_exp2f(t.y); }
                __builtin_amdgcn_sched_barrier(0);
#pragma unroll
                for (int i = 0; i < 4; ++i) ab[i] = (a2[i] * b2[i]) * r2;
                __builtin_amdgcn_sched_barrier(0);
#pragma unroll
                for (int i = 0; i < 4; ++i) { den[i] = den[i] + 1.0f; rc[i].x = __builtin_amdgcn_rcpf(den[i].x); rc[i].y = __builtin_amdgcn_rcpf(den[i].y); }
                __builtin_amdgcn_sched_barrier(0);
                f32x4 o[2];
#pragma unroll
                for (int i = 0; i < 4; ++i) { const f32x2 res = ab[i] * rc[i]; o[i >> 1][(i & 1) * 2] = res.x; o[i >> 1][(i & 1) * 2 + 1] = res.y; }
                *(u32x4*)(HID + (ai * 128 + m * 16) * FFH + lo) = pack8(o[0], o[1]); }
    }
};

namespace att {
using bf16 = __hip_bfloat16;
constexpr int D = 128;
constexpr float THR = 8.f;
constexpr bool WSKIP = false;
constexpr float SCALE = 0.08838834764831845f;
constexpr float QSC = 1.4426950408889634f * SCALE;
constexpr float THR2 = THR * 1.4426950408889634f;
constexpr int NW = 8, QBLK = 32, KVBLK = 64, QB = NW * QBLK;
constexpr int SHM_V = KVBLK * D * 2, SHM_K = KVBLK * D * 2;
constexpr int LDS_ATT = 2 * SHM_V + 2 * SHM_K + NW * 64 * 4;
template <class A, class Bt> struct same_t { static constexpr bool v = false; };
template <class A> struct same_t<A, A> { static constexpr bool v = true; };
#define KSWZ(row, colB) ((row) * 256 + ((colB) ^ (((row) & 7) << 4)))
#define SBAR() __builtin_amdgcn_sched_barrier(0)
__device__ __forceinline__ int v_st(int k, int c) { const int kk = (k & ~0xC) | ((k & 4) << 1) | ((k & 8) >> 1); return ((kk >> 3) * 4 + (c >> 5)) * 512 + ((kk & 7) * 32 + (c & 31)) * 2; }
__device__ __forceinline__ int v_rd_base(int lane) { return ((lane & 3) << 3) | (((lane >> 2) & 3) << 6) | (((lane >> 4) & 1) << 5) | (((lane >> 5) & 1) << 11); }
constexpr int v_rd_off(int d0, int ks, int half) { return d0 * 512 + ks * 4096 + half * 2048; }
__device__ __forceinline__ int crow(int r, int hi) { return (r & 3) + 8 * (r >> 2) + 4 * hi; }
__device__ __forceinline__ unsigned cvtpk(float lo, float hi) { return cvt_pk_bf16(lo, hi); }
__device__ __forceinline__ bf16x8 pack8(f32x4 a, f32x4 b) { u32x4 w = {cvtpk(a[0], a[1]), cvtpk(a[2], a[3]), cvtpk(b[0], b[1]), cvtpk(b[2], b[3])}; return *reinterpret_cast<bf16x8*>(&w); }
template <class T> __device__ __forceinline__ bf16x8 load8(const T* p) {
    if constexpr (same_t<T, float>::v) { return pack8(*(const f32x4*)p, *(const f32x4*)(p + 4)); }
    else { return *reinterpret_cast<const bf16x8*>(p); }
}
__device__ __forceinline__ void mask_tile(f32x16& p0, f32x16& p1, int dq, unsigned W) {
    const float NEG = -__builtin_inff();
#pragma unroll
    for (int r = 0; r < 16; ++r) {
        const int c = (r & 3) + 8 * (r >> 2);
        if ((unsigned)(dq - c) >= W) p0[r] = NEG;
        if ((unsigned)(dq - c - 32) >= W) p1[r] = NEG;
    }
}
__device__ __forceinline__ void partialSM(f32x16& p0, f32x16& p1, float& m_reg, f32x16& cneg, bool first, float& alpha) {
    float pm_[4] = {p0[0], p0[1], p0[2], p0[3]};
    for (int r = 4; r < 16; ++r) pm_[r & 3] = fmaxf(pm_[r & 3], p0[r]); for (int r = 0; r < 16; ++r) pm_[r & 3] = fmaxf(pm_[r & 3], p1[r]);
    float pmax = fmaxf(fmaxf(pm_[0], pm_[1]), fmaxf(pm_[2], pm_[3]));
    if (__builtin_expect(!first && __all(pmax <= THR2), 1)) { alpha = 1.f; }
    else { { auto rr = __builtin_amdgcn_permlane32_swap(__float_as_uint(pmax), __float_as_uint(pmax), false, false);
             pmax = fmaxf(__uint_as_float(rr[0]), __uint_as_float(rr[1])); }
        const float dl = first ? fmaxf(pmax, -1.0e4f) : fmaxf(pmax, 0.f);
        alpha = first ? 1.f : __builtin_amdgcn_exp2f(-dl); m_reg += dl;
        for (int r = 0; r < 16; ++r) { p0[r] -= dl; p1[r] -= dl; }
        const float nm = -m_reg; for (int r = 0; r < 16; ++r) cneg[r] = nm; }
    for (int r = 0; r < 16; ++r) p0[r] = __builtin_amdgcn_exp2f(p0[r]);
}
__device__ __forceinline__ void finishSM(f32x16& p0, f32x16& p1, float alpha, float& l_reg, bf16x8& pa0, bf16x8& pa1, bf16x8& pa2, bf16x8& pa3) {
    for (int r = 0; r < 16; ++r) p1[r] = __builtin_amdgcn_exp2f(p1[r]);
    float ps_[4] = {p0[0], p0[1], p0[2], p0[3]}; for (int r = 4; r < 16; ++r) ps_[r & 3] += p0[r]; for (int r = 0; r < 16; ++r) ps_[r & 3] += p1[r];
    const float ps = (ps_[0] + ps_[1]) + (ps_[2] + ps_[3]);
    l_reg = l_reg * alpha + ps;
#define PK4(P, B_, OUT) do { u32x4 w = {cvtpk(P[B_+0], P[B_+1]), cvtpk(P[B_+2], P[B_+3]), cvtpk(P[B_+4], P[B_+5]), cvtpk(P[B_+6], P[B_+7])}; OUT = *reinterpret_cast<bf16x8*>(&w); } while (0)
    PK4(p0, 0, pa0); PK4(p0, 8, pa1); PK4(p1, 0, pa2); PK4(p1, 8, pa3);
#undef PK4
}
template <int KB, bool SK>
__device__ __forceinline__ void qkt(f32x16& p0, f32x16& p1, const char* K_lds, int r32, int hi, const bf16x8* qr, bool act) {
    if (SK && !act) { const float NEG = -__builtin_inff();
#pragma unroll
        for (int r = 0; r < 16; ++r) { p0[r] = NEG; p1[r] = NEG; } return; }
    p0 = f32x16{}; p1 = f32x16{};
    const char* kb[4];
#pragma unroll
    for (int dd = 0; dd < 4; ++dd) kb[dd] = K_lds + KB * SHM_K + KSWZ(r32, (dd * 16 + hi * 8) * 2);
#pragma unroll
    for (int d0 = 0; d0 < 8; ++d0) { const char* a = kb[d0 & 3] + (d0 >> 2) * 128;
        bf16x8 b0 = *reinterpret_cast<const bf16x8*>(a);
        bf16x8 b1 = *reinterpret_cast<const bf16x8*>(a + 32 * 256);
        p0 = __builtin_amdgcn_mfma_f32_32x32x16_bf16(b0, qr[d0], p0, 0, 0, 0);
        p1 = __builtin_amdgcn_mfma_f32_32x32x16_bf16(b1, qr[d0], p1, 0, 0, 0); }
}
template <int VB, bool SK>
__device__ __forceinline__ void pv_tile(f32x16* o, int vb0, bf16x8 pa0, bf16x8 pa1, bf16x8 pa2, bf16x8 pa3, bool act) {
    if (SK && !act) return;
#define TRRD(dst, off) asm volatile("ds_read_b64_tr_b16 %0, %1 offset:%2" : "=&v"(dst) : "v"(vb0), "i"(off) : "memory")
#define PV_D0(d0) do { s16x4 l0, l1, l2, l3, h0, h1, h2, h3; constexpr int b_ = VB * SHM_V + v_rd_off(d0, 0, 0); \
        TRRD(l0, b_); TRRD(h0, b_ + 256); TRRD(l1, b_ + 4096); TRRD(h1, b_ + 4352); TRRD(l2, b_ + 8192); TRRD(h2, b_ + 8448); TRRD(l3, b_ + 12288); TRRD(h3, b_ + 12544); \
        asm volatile("s_waitcnt lgkmcnt(0)" ::: "memory"); SBAR();   \
        o[d0] = __builtin_amdgcn_mfma_f32_32x32x16_bf16(pa0, (bf16x8){l0[0], l0[1], l0[2], l0[3], h0[0], h0[1], h0[2], h0[3]}, o[d0], 0, 0, 0);   \
        o[d0] = __builtin_amdgcn_mfma_f32_32x32x16_bf16(pa1, (bf16x8){l1[0], l1[1], l1[2], l1[3], h1[0], h1[1], h1[2], h1[3]}, o[d0], 0, 0, 0);   \
        o[d0] = __builtin_amdgcn_mfma_f32_32x32x16_bf16(pa2, (bf16x8){l2[0], l2[1], l2[2], l2[3], h2[0], h2[1], h2[2], h2[3]}, o[d0], 0, 0, 0);   \
        o[d0] = __builtin_amdgcn_mfma_f32_32x32x16_bf16(pa3, (bf16x8){l3[0], l3[1], l3[2], l3[3], h3[0], h3[1], h3[2], h3[3]}, o[d0], 0, 0, 0); } while (0)
    PV_D0(0); PV_D0(1); PV_D0(2); PV_D0(3);
#undef PV_D0
#undef TRRD
}
#undef KSWZ
#undef SBAR
}

namespace datt {
using namespace att;
constexpr int STAGE = 65536, K_OFF = 0, V_OFF = 32768;
#define DSBAR() __builtin_amdgcn_sched_barrier(0)
#define DKSWZ(row, colB) ((row) * 256 + ((colB) ^ (((row) & 7) << 4)))
__device__ __forceinline__ void qkt_rt(f32x16& p0, f32x16& p1, int Kt  , int r32, int hi, const bf16x8* qr, const f32x16& cneg  ) {
    int kb[4];
#pragma unroll
    for (int dd = 0; dd < 4; ++dd) kb[dd] = Kt + DKSWZ(r32, (dd * 16 + hi * 8) * 2);
#define KRD(dst, a_, off) asm volatile("ds_read_b128 %0, %1 offset:%2" : "=&v"(dst) : "v"(a_), "i"(off) : "memory")
#define KWAIT(n) asm volatile("s_waitcnt lgkmcnt(" #n ")" ::: "memory")
    bf16x8 a0, a1, b0, b1;
    KRD(a0, kb[0], 0); KRD(a1, kb[0], 8192); KRD(b0, kb[1], 0); KRD(b1, kb[1], 8192);
#define QSTEP(d0, X0, X1, nd, NXT) do { if (NXT) KWAIT(2); else KWAIT(0); DSBAR(); \
        p0 = __builtin_amdgcn_mfma_f32_32x32x16_bf16(X0, qr[d0], p0, 0, 0, 0); p1 = __builtin_amdgcn_mfma_f32_32x32x16_bf16(X1, qr[d0], p1, 0, 0, 0); DSBAR(); \
        if (NXT) { KRD(X0, kb[(nd) & 3], ((nd) >> 2) * 128); KRD(X1, kb[(nd) & 3], ((nd) >> 2) * 128 + 8192); } } while (0)
    KWAIT(2); DSBAR(); p0 = __builtin_amdgcn_mfma_f32_32x32x16_bf16(a0, qr[0], cneg, 0, 0, 0); p1 = __builtin_amdgcn_mfma_f32_32x32x16_bf16(a1, qr[0], cneg, 0, 0, 0); DSBAR(); KRD(a0, kb[2 & 3], (2 >> 2) * 128); KRD(a1, kb[2 & 3], (2 >> 2) * 128 + 8192);
    QSTEP(1, b0, b1, 3, 1); QSTEP(2, a0, a1, 4, 1); QSTEP(3, b0, b1, 5, 1);
    QSTEP(4, a0, a1, 6, 1); QSTEP(5, b0, b1, 7, 1);
    KWAIT(2); DSBAR(); p0 = __builtin_amdgcn_mfma_f32_32x32x16_bf16(a0, qr[6], p0, 0, 0, 0); p1 = __builtin_amdgcn_mfma_f32_32x32x16_bf16(a1, qr[6], p1, 0, 0, 0);
    KWAIT(0); DSBAR(); p0 = __builtin_amdgcn_mfma_f32_32x32x16_bf16(b0, qr[7], p0, 0, 0, 0); p1 = __builtin_amdgcn_mfma_f32_32x32x16_bf16(b1, qr[7], p1, 0, 0, 0);
#undef QSTEP
#undef KWAIT
#undef KRD
}
template <int MODE>
__device__ __forceinline__ void dattn_unit(const bf16_t* QH, const bf16_t* KH, const bf16_t* VH, bf16_t* A2, int bh, int qb, float lamf  , const float* gain  , int lay  , char* lds, float* scr, const int tid, const int rot  ) {
    int tid_ = tid; asm volatile("" : "+v"(tid_));
    const int wid = __builtin_amdgcn_readfirstlane(tid_ >> 6), lane = tid_ & 63, r32 = lane & 31, hi = lane >> 5, c = wid >> 2, p = wid & 3;
    const int row0 = qb * 128, qlo = row0 + 32 * p, qm = qlo + r32 - 4 * hi, NT = 2 * qb + 2;
    const bf16_t* Qc = QH + ((size_t)(bh * 2 + c) * SEQ + qlo) * HDIM; const char* Kc = (const char*)(KH + (size_t)(bh * 2 + c) * SEQ * HDIM);
    const char* V0 = (const char*)(VH + (size_t)(bh * 2) * SEQ * HDIM);
    float* li_l = scr + wid * 64, * al_l = li_l + 32;
    const char* K1h = (const char*)(KH + (size_t)(bh * 2) * SEQ * HDIM); const char* K2h = K1h + (size_t)SEQ * HDIM * 2; const char* V1 = V0 + (size_t)SEQ * HDIM * 2;
#define DMA16(g, l_) __builtin_amdgcn_global_load_lds((const unsigned*)(g), (LAS unsigned*)(l_), 16, 0, 0)
    unsigned koff0_, voff0_;
    { const int row_ = 8 * wid + (lane >> 4), ch_ = (lane & 15) ^ (row_ & 7); koff0_ = (unsigned)(row_ * 256 + ch_ * 16);
      const int kk_ = 8 * wid + ((lane & 31) >> 2), k_ = (kk_ & ~0xC) | ((kk_ & 4) << 1) | ((kk_ & 8) >> 1), cc_ = 32 * (lane >> 5) + 8 * (lane & 3); voff0_ = (unsigned)(k_ * 256 + cc_ * 2); }
#define STAGE_TILE(t_, st_) do { const size_t kb_ = (size_t)(t_) * 64 * 256; LAS unsigned char* sb_ = lds_base() + (st_) * STAGE; \
        const unsigned koff1_ = (koff0_ ^ 64u) + 1024u, voff1_ = voff0_ + 128u; \
        DMA16(K1h + kb_ + koff0_, sb_ + K_OFF + (8 * wid) * 256); DMA16(K2h + kb_ + koff0_, sb_ + K_OFF + 16384 + (8 * wid) * 256); \
        DMA16(V0 + kb_ + voff0_, sb_ + V_OFF + (2 * wid) * 1024); DMA16(V1 + kb_ + voff0_, sb_ + V_OFF + 16384 + (2 * wid) * 1024); \
        DMA16(K1h + kb_ + koff1_, sb_ + K_OFF + (8 * wid + 4) * 256); DMA16(K2h + kb_ + koff1_, sb_ + K_OFF + 16384 + (8 * wid + 4) * 256); \
        DMA16(V0 + kb_ + voff1_, sb_ + V_OFF + (2 * wid + 1) * 1024); DMA16(V1 + kb_ + voff1_, sb_ + V_OFF + 16384 + (2 * wid + 1) * 1024); } while (0)
    bf16x8 qr[8];
#pragma unroll
    for (int d0 = 0; d0 < 8; ++d0) qr[d0] = *reinterpret_cast<const bf16x8*>(Qc + (unsigned)(r32 * HDIM + d0 * 16 + hi * 8));
    if (MODE != 4) STAGE_TILE(rot, 0);
    float m_reg = 0.f, l_reg = 0.f; f32x16 o[8] = {};
    f32x16 cneg = {};
    f32x16 p0, p1; float alpha; bf16x8 pa0, pa1, pa2, pa3; bool fresh = true;
    const int vrb = v_rd_base(lane);
    for (int i = 0; i < NT; ++i) { int t = i + rot; if (t >= NT) t -= NT; int tn = t + 1; if (tn >= NT) tn = 0;
        asm volatile("s_waitcnt vmcnt(0)" ::: "memory"); __builtin_amdgcn_s_barrier(); asm volatile("" ::: "memory");
        const int kbase = t * 64; const bool act = kbase <= qlo + 31;
        if (MODE != 4 && i + 1 < NT) STAGE_TILE(tn, (i + 1) & 1);
        if (act) { const int Kt = (i & 1) * STAGE + K_OFF + c * 16384;
            DSBAR(); if (MODE != 3) qkt_rt(p0, p1, Kt, r32, hi, qr, cneg); else { p0 = f32x16{}; p1 = f32x16{}; } DSBAR(); }
        if (act) {
            if (kbase + 63 > qlo) mask_tile(p0, p1, qm - kbase, 0x7fffffffu);
            if (MODE != 1) { partialSM(p0, p1, m_reg, cneg, fresh, alpha); fresh = false;
            finishSM(p0, p1, alpha, l_reg, pa0, pa1, pa2, pa3); } else { alpha = 1.f; l_reg = 1.f; pa0 = att::pack8((f32x4){p0[0],p0[1],p0[2],p0[3]}, (f32x4){p0[4],p0[5],p0[6],p0[7]}); pa1 = att::pack8((f32x4){p0[8],p0[9],p0[10],p0[11]}, (f32x4){p0[12],p0[13],p0[14],p0[15]}); pa2 = att::pack8((f32x4){p1[0],p1[1],p1[2],p1[3]}, (f32x4){p1[4],p1[5],p1[6],p1[7]}); pa3 = att::pack8((f32x4){p1[8],p1[9],p1[10],p1[11]}, (f32x4){p1[12],p1[13],p1[14],p1[15]}); } DSBAR();
            if (__any(alpha < 1.f)) { if (hi == 0) al_l[r32] = alpha; asm volatile("s_waitcnt lgkmcnt(0)" ::: "memory");
#pragma unroll
                for (int d_ = 0; d_ < 8; ++d_)
#pragma unroll
                    for (int r = 0; r < 16; ++r) o[d_][r] *= al_l[crow(r, hi)]; }
            const int vb = (i & 1) * STAGE + V_OFF + vrb;
            if (MODE != 2) { pv_tile<0, false>(o, vb, pa0, pa1, pa2, pa3, true); pv_tile<0, false>(o + 4, vb + 16384, pa0, pa1, pa2, pa3, true); } else { o[0][0] += __uint_as_float((unsigned)pa0[0] + (unsigned)pa1[0] + (unsigned)pa2[0] + (unsigned)pa3[0]); }
        }
    }
    { auto rr = __builtin_amdgcn_permlane32_swap(__float_as_uint(l_reg), __float_as_uint(l_reg), false, false); l_reg = __uint_as_float(rr[0]) + __uint_as_float(rr[1]); }
    if (hi == 0) li_l[r32] = (c ? lamf : 1.0f) * __builtin_amdgcn_rcpf(l_reg);
    asm volatile("s_waitcnt lgkmcnt(0)" ::: "memory");
    float rli[16];
#pragma unroll
    for (int r = 0; r < 16; ++r) rli[r] = li_l[crow(r, hi)];
    __builtin_amdgcn_s_barrier(); asm volatile("" ::: "memory");
    LAS float* ex = (LAS float*)(lds_base() + p * 32768);
    if (c == 1) {
#pragma unroll
        for (int d0 = 0; d0 < 8; ++d0)
#pragma unroll
            for (int r = 0; r < 16; ++r) ex[crow(r, hi) * 256 + d0 * 32 + r32] = o[d0][r] * rli[r];
    }
    asm volatile("s_waitcnt lgkmcnt(0)" ::: "memory"); __builtin_amdgcn_s_barrier(); asm volatile("" ::: "memory");
    if (c == 0) {
#pragma unroll
        for (int d0 = 0; d0 < 8; ++d0)
#pragma unroll
            for (int r = 0; r < 16; ++r) { const int a = crow(r, hi) * 256 + d0 * 32 + r32; ex[a] = o[d0][r] * rli[r] - ex[a]; }
    }
    asm volatile("s_waitcnt lgkmcnt(0)" ::: "memory"); __builtin_amdgcn_s_barrier(); asm volatile("" ::: "memory");
    {
        const int b = bh >> 3, h = bh & 7;
        bf16_t* outp = A2 + ((size_t)(b * SEQ + row0 + 16 * wid)) * KBR + h * 256;
        int lay_ = lay; asm volatile("" : "+s"(lay_));
        const float gsc_ = 1.0f - (0.8f - 0.6f * expf(-0.3f * (float)lay_));
        const f32x4 gain4 = *(const f32x4*)(gain + 4 * lane) * gsc_;
#pragma unroll 4
        for (int i = 0; i < 16; ++i) { const int R = 16 * wid + i;
            const f32x4 x = *(const LAS f32x4*)(lds_base() + (R >> 5) * 32768 + (R & 31) * 1024 + lane * 16);
            const float ss = wave_sum((x[0] * x[0] + x[1] * x[1]) + (x[2] * x[2] + x[3] * x[3]), lane);
            const float rs = __builtin_amdgcn_rsqf(ss * (1.0f / 256.0f) + EPS); const f32x4 y = x * rs * gain4;
            u32x2 w; w.x = cvt_pk_bf16(y[0], y[1]); w.y = cvt_pk_bf16(y[2], y[3]); *(u32x2*)(outp + (size_t)i * KBR + (unsigned)(4 * lane)) = w; }
    }
    asm volatile("s_waitcnt lgkmcnt(0)" ::: "memory"); __builtin_amdgcn_s_barrier(); asm volatile("" ::: "memory");
#undef STAGE_TILE
#undef DMA16
}

#undef DSBAR
#undef DKSWZ
}

#define XB_TMO      128
#define XB_XCNT(j)  (256  + 64 * (j))
#define XB_XSUB(j)  (1280 + 64 * (j))
#define XB_XGEN(j)  (2304 + 64 * (j))
#define XB_TOP      3328
#define XB_TOPGEN   3392
#define XCD_BAR_WORDS 3456
#define XB_SPIN_CAP (1u << 18)
__device__ __forceinline__ unsigned xb_ld(unsigned* p)              { return __hip_atomic_load(p, __ATOMIC_RELAXED, __HIP_MEMORY_SCOPE_AGENT); }
__device__ __forceinline__ unsigned xb_add(unsigned* p, unsigned v) { return __hip_atomic_fetch_add(p, v, __ATOMIC_RELAXED, __HIP_MEMORY_SCOPE_AGENT); }
__device__ __forceinline__ unsigned xb_xcc_id() { return (unsigned)__builtin_amdgcn_s_getreg((3 << 11) | 20) & 0xFu; }
#define XB_SPIN(cond, bar) do { unsigned _sp = 0; while (cond) { __builtin_amdgcn_s_sleep(1); \
    if ((++_sp & 255u) == 0u) { if (xb_ld(&(bar)[XB_TMO])) break; if (_sp > XB_SPIN_CAP) { atomicAdd(&(bar)[XB_TMO], 1u); break; } } } } while (0)
struct XcdBarrier { unsigned* bar; unsigned x; volatile LAS unsigned* st; };
__device__ __forceinline__ XcdBarrier xcd_barrier_post(unsigned* bar, volatile LAS unsigned* st, const bool leader) {
    XcdBarrier b; b.bar = bar; b.x = xb_xcc_id(); b.st = st;
    if (leader) (void)xb_add(&bar[XB_XCNT(b.x)], 1u);
    return b;
}
__device__ __forceinline__ void xcd_barrier_complete(unsigned* bar, unsigned x, unsigned& nloc, unsigned& nx) {
    const unsigned G = gridDim.x * gridDim.y * gridDim.z;
    unsigned sum, cnt, mine, sp = 0u;
    for (;;) {
        sum = 0u; cnt = 0u; mine = 0u;
#pragma unroll
        for (unsigned j = 0; j < 16; ++j) { const unsigned c = xb_ld(&bar[XB_XCNT(j)]); sum += c; cnt += (c > 0u) ? 1u : 0u; mine = (j == x) ? c : mine; }
        if (sum == G) break;
        __builtin_amdgcn_s_sleep(1);
        if ((++sp & 255u) == 0u) { if (xb_ld(&bar[XB_TMO])) break; if (sp > XB_SPIN_CAP) { atomicAdd(&bar[XB_TMO], 1u); break; } }
    }
    nloc = mine > 0u ? mine : 1u; nx = cnt > 0u ? cnt : 1u;
}
__device__ __forceinline__ void xcd_barrier(const XcdBarrier& b, const bool leader) {
    asm volatile("s_waitcnt vmcnt(0)" ::: "memory");
    __syncthreads();
    if (leader) {
        unsigned* bar = b.bar;
        __builtin_amdgcn_s_waitcnt(0);
        unsigned nloc = b.st[0], nx = b.st[1];
        if (nloc == 0u) { xcd_barrier_complete(bar, b.x, nloc, nx); b.st[0] = nloc; b.st[1] = nx; }
        const unsigned old = xb_add(&bar[XB_XSUB(b.x)], 1u);
        const unsigned gen = old / nloc;
        if (old + 1u == (gen + 1u) * nloc) {
            __builtin_amdgcn_fence(__ATOMIC_RELEASE, "agent");
            asm volatile("s_waitcnt vmcnt(0)" ::: "memory");
            const unsigned og = xb_add(&bar[XB_TOP], 1u);
            const unsigned tg = og / nx;
            if (og + 1u == (tg + 1u) * nx) xb_add(&bar[XB_TOPGEN], 1u);
            else XB_SPIN(xb_ld(&bar[XB_TOPGEN]) == tg, bar);
            __builtin_amdgcn_fence(__ATOMIC_ACQUIRE, "agent");
            xb_add(&bar[XB_XGEN(b.x)], 1u);
            asm volatile("s_waitcnt vmcnt(0)" ::: "memory");
        } else {
            XB_SPIN(xb_ld(&bar[XB_XGEN(b.x)]) == gen, bar);
            __builtin_amdgcn_fence(__ATOMIC_ACQUIRE, "agent");
            asm volatile("s_waitcnt vmcnt(0)" ::: "memory");
        }
    }
    __syncthreads();
}

struct TrItem { const float* W; const float* gain; bf16_t* WT; int ldw, src0, ldo, n0, kcol0, k0; float osc; };
__device__ __forceinline__ void transpose_load(const TrItem& d, f32x4 (&v)[16], int lane) {
    const int rsub = lane >> 4, c4 = lane & 15;
    const float* wp = d.W + (size_t)(d.k0 + rsub) * d.ldw + d.src0; const unsigned lo = 4u * c4;
#pragma unroll
    for (int i = 0; i < 16; ++i) v[i] = __builtin_nontemporal_load((const f32x4*)(wp + (size_t)(4 * i) * d.ldw + lo));
}
__device__ __forceinline__ void transpose_finish(const TrItem& d, f32x4 (&v)[16], LAS float* scr, int lane) {
    const int rsub = lane >> 4, c4 = lane & 15;
    if (d.gain) {
#pragma unroll
        for (int i = 0; i < 16; ++i) v[i] = v[i] * (d.gain[d.k0 + 4 * i + rsub] * d.osc); }
#pragma unroll
    for (int i = 0; i < 16; ++i) { LAS float* p = scr + (4 * i + rsub) * 65 + 4 * c4; p[0] = v[i][0]; p[1] = v[i][1]; p[2] = v[i][2]; p[3] = v[i][3]; }
    asm volatile("s_waitcnt lgkmcnt(0)" ::: "memory");
    const int c = lane & 7, nl = lane >> 3;
    bf16_t* op = d.WT + (size_t)d.n0 * d.ldo + d.kcol0 + d.k0; const unsigned so = (unsigned)nl * d.ldo + 8u * c;
#pragma unroll
    for (int j = 0; j < 8; ++j) { const LAS float* sp = scr + (8 * c) * 65 + nl + 8 * j;
        u32x4 o; o.x = cvt_pk_bf16(sp[0 * 65], sp[1 * 65]); o.y = cvt_pk_bf16(sp[2 * 65], sp[3 * 65]); o.z = cvt_pk_bf16(sp[4 * 65], sp[5 * 65]); o.w = cvt_pk_bf16(sp[6 * 65], sp[7 * 65]);
        *(u32x4*)(op + (size_t)(8 * j) * d.ldo + so) = o; }
    asm volatile("s_waitcnt lgkmcnt(0)" ::: "memory");
}
__device__ __forceinline__ int src_in(int n) {
    if (n >= 10240) { const int g = (n - 10240) >> 8, w = n & 255; return 10240 + (w >> 7) * 2048 + g * 128 + (w & 127); }
    if (n >= 4096) return n;
    const int r = n >> 11, nn = n & 2047, h = nn >> 8, w = nn & 255, bj = w >> 7, c = (w >> 6) & 1, d = w & 63;
    return r * 2048 + h * 256 + c * 128 + bj * 64 + d;
}
__device__ __forceinline__ int src_ffi(int n) { const int pn = n >> 8, w = n & 255, bj = w >> 7, p = w & 127; return bj * FFH + pn * 128 + p; }

#define PH_ARGS() ArgP ap = get_args(); unsigned char* ws = ap->ws; (void)ws; int bid_ = blockIdx.x, G_ = gridDim.x; asm volatile("" : "+s"(bid_), "+s"(G_)); (void)bid_; (void)G_
__global__ void __launch_bounds__(512, 2) mk_fwd(Args args_unused) {
    LAS unsigned char* lds = lds_base();
    volatile LAS unsigned* MISC = (volatile LAS unsigned*)(lds + MISC_OFF);
    const int wv = __builtin_amdgcn_readfirstlane((int)threadIdx.x >> 6);
    for (int u = TID_OF(wv); u < (LDS_BYTES - MISC_OFF) / 4; u += 512) MISC[u] = 0u;
    __syncthreads();
    XcdBarrier bar; bar.bar = nullptr; bar.x = 0; bar.st = nullptr;
    if (!MK_MULTI) { ArgP ap0 = get_args(); bar = xcd_barrier_post((unsigned*)(ap0->ws + WS_CTL) + CW_BAR, MISC + 8, TID_OF(wv) == 0); }
    int lo, hi; { ArgP ap0 = get_args(); lo = ap0->ph_lo; hi = ap0->ph_hi; }
#define IN(k) (lo <= (k) && (k) < hi && (DBG_CUT == 0 || (k) < DBG_CUT || (k) == 29))
#define GRID_BAR(k) do { if (IN(k) && IN((k) + 1)) xcd_barrier(bar, TID_OF(wv) == 0); } while (0)

    for (int rep = 0; rep < REP_P0; ++rep)
    if (EN_P0 && IN(0)) {
        PH_ARGS();
        const int tid = TID_OF(wv), lane = tid & 63, wid = wv, G = gridDim.x, bid = blockIdx.x, gw = bid * 8 + wid, NGW = G * 8;
        LAS float* scr = (LAS float*)(lds + wid * 16640);
        constexpr int NB_IN = INCOLS / 64, NB_D = DM / 64, NB_FI = 2 * FFH / 64, KB_D = DM / 64, KB_FO = FFH / 64;
        constexpr int I_IN = KB_D * NB_IN, I_BR = KB_D * NB_D, I_OUT = I_BR, I_FI = KB_D * NB_FI, I_FO = KB_FO * NB_D;
        constexpr int I_LAYER = I_IN + 2 * I_BR + I_OUT + I_FI + I_FO;
        auto decode = [&](int it) -> TrItem { const int l = it / I_LAYER; int r = it - l * I_LAYER; TrItem d;
            if (r < I_IN) { const int kb = r / NB_IN, nb = r - kb * NB_IN, n0 = nb * 64;
                d = TrItem{ap->w_in + (size_t)l * DM * INCOLS, ap->norm_attn + l * DM, (bf16_t*)(ws + WS_WIN + l * SZ_WIN), INCOLS, src_in(n0), DM, n0, 0, kb * 64, n0 < DM ? att::QSC : 1.0f}; return d; }
            r -= I_IN;
            if (r < 2 * I_BR) { const int br = r / I_BR, rr = r - br * I_BR, kb = rr / NB_D, nb = rr - kb * NB_D, n0 = nb * 64;
                d = TrItem{ap->w_branch + ((size_t)l * 2 + br) * DM * DM, nullptr, (bf16_t*)(ws + WS_WBR + l * SZ_WBR), DM, n0, KBR, n0, br * DM, kb * 64, 1.0f}; return d; }
            r -= 2 * I_BR;
            if (r < I_OUT) { const int kb = r / NB_D, nb = r - kb * NB_D, n0 = nb * 64;
                d = TrItem{ap->w_out + (size_t)l * DM * DM, nullptr, (bf16_t*)(ws + WS_WOUT + l * SZ_WOUT), DM, n0, DM, n0, 0, kb * 64, 1.0f}; return d; }
            r -= I_OUT;
            if (r < I_FI) { const int kb = r / NB_FI, nb = r - kb * NB_FI, n0 = nb * 64;
                d = TrItem{ap->w_ffn_in + (size_t)l * DM * 2 * FFH, ap->norm_ffn + l * DM, (bf16_t*)(ws + WS_WFI + l * SZ_WFI), 2 * FFH, src_ffi(n0), DM, n0, 0, kb * 64, 1.0f}; return d; }
            r -= I_FI;
            { const int kb = r / NB_D, nb = r - kb * NB_D, n0 = nb * 64;
                d = TrItem{ap->w_ffn_out + (size_t)l * FFH * DM, nullptr, (bf16_t*)(ws + WS_WFO + l * SZ_WFO), DM, n0, FFH, n0, 0, kb * 64, 1.0f}; return d; } };
        for (int it = gw; it < DEPTH * I_LAYER; it += 2 * NGW) {
            const bool two = it + NGW < DEPTH * I_LAYER;
            const TrItem d0 = decode(it), d1 = decode(two ? it + NGW : it);
            f32x4 v0[16], v1[16];
            transpose_load(d0, v0, lane); if (two) transpose_load(d1, v1, lane);
            transpose_finish(d0, v0, scr, lane); if (two) transpose_finish(d1, v1, scr, lane);
        }
        { bf16_t* XB = (bf16_t*)(ws + WS_XB); float* SSQ = (float*)(ws + WS_SSQ); const float* x = ap->x;
        for (int m = gw; m < MTOK; m += NGW) {
            const f32x4* xr = (const f32x4*)(x + (size_t)m * DM) + lane; float s = 0.f;
#pragma unroll
            for (int j = 0; j < 8; ++j) { const f32x4 v = xr[64 * j]; s += (v[0] * v[0] + v[1] * v[1]) + (v[2] * v[2] + v[3] * v[3]);
                u32x2 w; w.x = cvt_pk_bf16(v[0], v[1]); w.y = cvt_pk_bf16(v[2], v[3]); *((u32x2*)(XB + (size_t)m * DM) + lane + 64 * j) = w; }
            s = wave_sum(s, lane);
            if (lane < 8) SSQ[(size_t)m * 8 + lane] = lane == 0 ? s : 0.f;
        } }
        { _Float16* COS = (_Float16*)(ws + WS_COS); _Float16* SIN = (_Float16*)(ws + WS_SIN); const int* pos = ap->pos;
        for (int i = bid * 512 + tid; i < MTOK * 64; i += G * 512) { const int m = i >> 6, d = i & 63;
            const float inv = powf(10000.0f, -(float)(2 * d) * (1.0f / 128.0f)); const float ang = (float)pos[m] * inv;
            const double t = (double)ang * 0.15915494309189535; const float fr = (float)(t - rint(t));
            COS[i] = (_Float16)__builtin_amdgcn_cosf(fr); SIN[i] = (_Float16)__builtin_amdgcn_sinf(fr); } }
        { bf16_t* WST = (bf16_t*)(ws + WS_WST); const float* wsp = ap->w_spatial;
        for (int i = bid * 512 + tid; i < DEPTH * 8 * 128 * 128; i += G * 512) { const int jj = i & 127, ii = (i >> 7) & 127; const float v = jj <= ii ? wsp[i] : 0.f; WST[i] = (bf16_t)(cvt_pk_bf16(v, 0.f) & 0xffffu); } }
    }
    GRID_BAR(0);

    for (int l = 0; l < DEPTH; ++l) {
        const int pb = 1 + 7 * l;
        for (int rep = 0; rep < REP_P1; ++rep)
        if (EN_P1 && IN(pb)) {
            PH_ARGS();
            pg8::Gemm g{(const bf16_t*)(ws + WS_XB), (const bf16_t*)(ws + WS_WIN + l * SZ_WIN), MTOK, INCOLS, DM}; pg8::StaticOrder S; S.init(MTOK, INCOLS, G_, bid_, DBG_ROT);
            pg8::Unit u0; const int pm0 = S.next(0, u0) ? u0.pm : -1;
            if (pm0 >= 0) panel_rstd_to_lds((const float*)(ws + WS_SSQ), pm0, TID_OF(wv));
            __syncthreads();
            EpiIn E{l, pm0};
            pg8::gemm_phase<EpiIn>(lds, g, S, E, wv);
        }
        GRID_BAR(pb);
        if (IN(pb + 1)) {
            for (int rep = 0; rep < REP_ATT; ++rep)
            if (EN_ATT) {
                PH_ARGS();
                const bf16_t* QH = (const bf16_t*)(ws + WS_QH); const bf16_t* KH = (const bf16_t*)(ws + WS_KH); const bf16_t* VH = (const bf16_t*)(ws + WS_VH); bf16_t* A2 = (bf16_t*)(ws + WS_A2);
                int tid = TID_OF(wv); asm volatile("" : "+v"(tid)); const int lane = tid & 63;
                const float lam_init = 0.8f - 0.6f * expf(-0.3f * (float)l);
                const float* lp = ap->lam + l * 512;
                const float s1 = wave_sum(lp[lane] * lp[128 + lane] + lp[64 + lane] * lp[192 + lane], lane), s2 = wave_sum(lp[256 + lane] * lp[384 + lane] + lp[320 + lane] * lp[448 + lane], lane);
                const float lamf = __int_as_float(__builtin_amdgcn_readfirstlane(__float_as_int(expf(s1) - expf(s2) + lam_init)));
                const float* gn = ap->subln + l * 256; const int gsc = l;
                float* scr = (float*)(lds_raw + XS_OFF);
                for (int L = bid_; L < 512; L += G_) { const int xcd = L & 7, k = L >> 3, x = k & 15, bh = (k >> 4) * 8 + xcd;
                    datt::dattn_unit<0>(QH, KH, VH, A2, bh, 31 - x, lamf, gn, gsc, (char*)lds_raw, scr, TID_OF(wv), ATT_ROT ? x : 0);
                    datt::dattn_unit<0>(QH, KH, VH, A2, bh, x, lamf, gn, gsc, (char*)lds_raw, scr, TID_OF(wv), 0);
#if ATT_PROBE
                    datt::dattn_unit<ATT_PROBE>(QH, KH, VH, (bf16_t*)(ws + WS_OH), bh, 31 - x, lamf, gn, gsc, (char*)lds_raw, scr, TID_OF(wv), ATT_ROT ? x : 0);
                    datt::dattn_unit<ATT_PROBE>(QH, KH, VH, (bf16_t*)(ws + WS_OH), bh, x, lamf, gn, gsc, (char*)lds_raw, scr, TID_OF(wv), 0);
#endif
                    }
            }
            __syncthreads();
            for (int rep = 0; rep < REP_SGU; ++rep)
            if (EN_SGU) {
                PH_ARGS();
                int tid_ = TID_OF(wv); asm volatile("" : "+v"(tid_));
                const int tid = tid_, lane = tid & 63, wid = wv;
                const float* LNST = (const float*)(ws + WS_LNST); const bf16_t* WST = (const bf16_t*)(ws + WS_WST); const bf16_t* GV = (const bf16_t*)(ws + WS_GV); const bf16_t* U = (const bf16_t*)(ws + WS_U); bf16_t* A2 = (bf16_t*)(ws + WS_A2);
                const float* ln_g = ap->sgu_ln_g + l * DM; const float* ln_b = ap->sgu_ln_b + l * DM; const float* b_sp = ap->b_spatial + l * 8 * 128;
                constexpr int WT_OFF = 0, XT_OFF = 34816, ST_OFF = 104448, RS = 272;
                LAS f32x2* ST = (LAS f32x2*)(lds + ST_OFF);
                const int r32 = lane & 31, hi = lane >> 5;
                for (int unit = bid_; unit < 1024; unit += G_) {
                    const int ch = unit >> 3, g = unit & 7, m0 = ch * 128;
                    const int cg = wid * 4 + (lane & 3), c0 = g * 256 + cg * 8;
                    u32x4 gvv[4][2]; u32x2 uuv[4][4]; u32x4 wv4[4]; f32x4 sa = {0.f, 0.f, 0.f, 0.f}, sb = sa, sc = sa, sd = sa;
                    if (tid < 128) { const f32x4* p = (const f32x4*)(LNST + (size_t)(m0 + tid) * 16); sa = p[0]; sb = p[1]; sc = p[2]; sd = p[3]; }
                    { const bf16_t* wsrc = WST + (size_t)(l * 8 + g) * 128 * 128;
#pragma unroll
                        for (int i = 0; i < 4; ++i) { const int chunk = tid + 512 * i, row = chunk >> 4, cc = chunk & 15; wv4[i] = *(const u32x4*)(wsrc + row * 128 + cc * 8); } }
#pragma unroll
                    for (int it = 0; it < 4; ++it) { const int j = 2 * (it * 16 + (lane >> 2)); gvv[it][0] = *(const u32x4*)(GV + (size_t)(m0 + j) * DM + c0); gvv[it][1] = *(const u32x4*)(GV + (size_t)(m0 + j + 1) * DM + c0); }
#pragma unroll
                    for (int ib = 0; ib < 4; ++ib)
#pragma unroll
                        for (int rg = 0; rg < 4; ++rg) uuv[ib][rg] = *(const u32x2*)(U + (size_t)(m0 + 32 * ib + r32) * DM + g * 256 + 32 * wid + 8 * rg + 4 * hi);
                    const f32x4 lg0 = *(const f32x4*)(ln_g + c0), lg1 = *(const f32x4*)(ln_g + c0 + 4), lb0 = *(const f32x4*)(ln_b + c0), lb1 = *(const f32x4*)(ln_b + c0 + 4);
                    if (tid < 128) { const f32x4 a = sa, b = sb, c = sc, d = sd;
                        const float s1 = ((a[0] + a[2]) + (b[0] + b[2])) + ((c[0] + c[2]) + (d[0] + d[2])), s2 = ((a[1] + a[3]) + (b[1] + b[3])) + ((c[1] + c[3]) + (d[1] + d[3]));
                        const float mean = s1 * (1.0f / DM), var = fmaxf(s2 * (1.0f / DM) - mean * mean, 0.f); ST[tid] = (f32x2){mean, 1.0f / sqrtf(var + EPS)}; }
#pragma unroll
                    for (int i = 0; i < 4; ++i) { const int chunk = tid + 512 * i, row = chunk >> 4, cc = chunk & 15; *(LAS u32x4*)(lds + WT_OFF + row * RS + cc * 16) = wv4[i]; }
                    __syncthreads();
                    {
#pragma unroll
                        for (int it = 0; it < 4; ++it) { const int j = 2 * (it * 16 + (lane >> 2));
                            const u32x4 v0 = gvv[it][0], v1 = gvv[it][1];
                            const f32x2 st0 = ST[j], st1 = ST[j + 1];
#pragma unroll
                            for (int q = 0; q < 4; ++q) { const float ga = q < 2 ? lg0[2 * q] : lg1[2 * q - 4], gb = q < 2 ? lg0[2 * q + 1] : lg1[2 * q - 3], ba = q < 2 ? lb0[2 * q] : lb1[2 * q - 4], bb = q < 2 ? lb0[2 * q + 1] : lb1[2 * q - 3];
                                const float a0 = (bf_lo(v0[q]) - st0.x) * st0.y * ga + ba, a1 = (bf_lo(v1[q]) - st1.x) * st1.y * ga + ba;
                                const float b0 = (bf_hi(v0[q]) - st0.x) * st0.y * gb + bb, b1 = (bf_hi(v1[q]) - st1.x) * st1.y * gb + bb;
                                *(LAS unsigned*)(lds + XT_OFF + (cg * 8 + 2 * q) * RS + j * 2) = cvt_pk_bf16(a0, a1);
                                *(LAS unsigned*)(lds + XT_OFF + (cg * 8 + 2 * q + 1) * RS + j * 2) = cvt_pk_bf16(b0, b1); } } }
                    __syncthreads();
                    f32x16 acc[4] = {};
#pragma unroll
                    for (int ks = 0; ks < 8; ++ks) { const bf16x8 a = *(const LAS bf16x8*)(lds + XT_OFF + (32 * wid + r32) * RS + (16 * ks + 8 * hi) * 2);
#pragma unroll
                        for (int ib = 0; ib < 4; ++ib) if (ks <= 2 * ib + 1) { const bf16x8 b = *(const LAS bf16x8*)(lds + WT_OFF + (32 * ib + r32) * RS + (16 * ks + 8 * hi) * 2);
                            acc[ib] = __builtin_amdgcn_mfma_f32_32x32x16_bf16(a, b, acc[ib], 0, 0, 0); } }
#pragma unroll
                    for (int ib = 0; ib < 4; ++ib) { const int i = 32 * ib + r32; const float bs = b_sp[g * 128 + i];
#pragma unroll
                        for (int rg = 0; rg < 4; ++rg) { const int cc = g * 256 + 32 * wid + 8 * rg + 4 * hi;
                            const u32x2 uu = uuv[ib][rg];
                            const f32x4 ug = gelu4((f32x4){bf_lo(uu.x), bf_hi(uu.x), bf_lo(uu.y), bf_hi(uu.y)});
                            u32x2 o; o.x = cvt_pk_bf16(ug[0] * (acc[ib][4 * rg] + bs), ug[1] * (acc[ib][4 * rg + 1] + bs)); o.y = cvt_pk_bf16(ug[2] * (acc[ib][4 * rg + 2] + bs), ug[3] * (acc[ib][4 * rg + 3] + bs));
                            *(u32x2*)(A2 + (size_t)(m0 + i) * KBR + DM + cc) = o; } }
                    __syncthreads();
                }
            }
        }
        GRID_BAR(pb + 1);
        for (int rep = 0; rep < REP_P4; ++rep)
        if (EN_P4 && IN(pb + 3)) {
            PH_ARGS();
            pg8::Gemm g{(const bf16_t*)(ws + WS_A2), (const bf16_t*)(ws + WS_WBR + l * SZ_WBR), MTOK, DM, KBR}; pg8::StaticOrder S; S.init(MTOK, DM, G_, bid_);
            EpiBranch E{};
            pg8::gemm_phase<EpiBranch>(lds, g, S, E, wv);
        }
        GRID_BAR(pb + 3);
        if (EN_P5 && IN(pb + 4)) {
            PH_ARGS();
            pg8::Gemm g{(const bf16_t*)(ws + WS_MRG), (const bf16_t*)(ws + WS_WOUT + l * SZ_WOUT), MTOK, DM, DM}; pg8::StaticOrder S; S.init(MTOK, DM, G_, bid_);
            EpiResid E{l == 0 ? 1 : 0, 0};
            pg8::gemm_phase<EpiResid>(lds, g, S, E, wv);
        }
        GRID_BAR(pb + 4);
        for (int rep = 0; rep < REP_P6; ++rep)
        if (EN_P6 && IN(pb + 5)) {
            PH_ARGS();
            pg8::Gemm g{(const bf16_t*)(ws + WS_XB), (const bf16_t*)(ws + WS_WFI + l * SZ_WFI), MTOK, 2 * FFH, DM}; pg8::StaticOrder S; S.init(MTOK, 2 * FFH, G_, bid_);
            pg8::Unit u0; const int pm0 = S.next(0, u0) ? u0.pm : -1;
            if (pm0 >= 0) panel_rstd_to_lds((const float*)(ws + WS_SSQ), pm0, TID_OF(wv));
            __syncthreads();
            EpiSwiglu E{pm0, (REP_P6_SKIPEPI && rep > 0) ? 1 : 0};
            pg8::gemm_phase<EpiSwiglu>(lds, g, S, E, wv);
        }
        GRID_BAR(pb + 5);
        if (EN_P7 && IN(pb + 6)) {
            PH_ARGS();
            pg8::Gemm g{(const bf16_t*)(ws + WS_HID), (const bf16_t*)(ws + WS_WFO + l * SZ_WFO), MTOK, DM, FFH}; pg8::StaticOrder S; S.init(MTOK, DM, G_, bid_);
            EpiResid E{0, l == DEPTH - 1 ? 1 : 0};
            pg8::gemm_phase<EpiResid>(lds, g, S, E, wv);
        }
        GRID_BAR(pb + 6);
    }
    if (DBG_CUT > 0) {
        if (IN(29)) { PH_ARGS(); float* out = ap->out; const int tid = TID_OF(wv);
            for (size_t i = (size_t)bid_ * 512 + tid; i < (size_t)MTOK * DM; i += (size_t)G_ * 512) { const size_t m = i >> 11, c = i & 2047; float v = 0.f;
                if (DBG_SRC == 1) { const bf16_t* A2 = (const bf16_t*)(ws + WS_A2); v = __uint_as_float((unsigned)A2[m * KBR + c] << 16) + __uint_as_float((unsigned)A2[m * KBR + DM + c] << 16); }
                if (DBG_SRC == 2) { const bf16_t* p = (const bf16_t*)(ws + WS_QH); v = __uint_as_float((unsigned)p[i] << 16) + __uint_as_float((unsigned)p[i + (size_t)MTOK * DM] << 16) + __uint_as_float((unsigned)p[i + 2 * (size_t)MTOK * DM] << 16); }
                if (DBG_SRC == 3) { const bf16_t* p = (const bf16_t*)(ws + WS_U); v = __uint_as_float((unsigned)p[i] << 16) + __uint_as_float((unsigned)p[i + (size_t)MTOK * DM] << 16) + __uint_as_float((unsigned)p[i + 2 * (size_t)MTOK * DM] << 16) + __uint_as_float((unsigned)p[i + 3 * (size_t)MTOK * DM] << 16) + ((const float*)(ws + WS_LNST))[i & (MTOK * 16 - 1)]; }
                if (DBG_SRC == 8) { const bf16_t* p = (const bf16_t*)(ws + WS_GA); v = __uint_as_float((unsigned)p[i] << 16) + __uint_as_float((unsigned)p[i + (size_t)MTOK * DM] << 16); }
                if (DBG_SRC == 9) { const bf16_t* p = (const bf16_t*)(ws + WS_U); v = __uint_as_float((unsigned)p[i] << 16) + __uint_as_float((unsigned)p[i + (size_t)MTOK * DM] << 16); }
                if (DBG_SRC == 4) { v = ((const float*)(ws + WS_X))[i] + ((const float*)(ws + WS_SSQ))[i & (MTOK * 8 - 1)]; }
                if (DBG_SRC == 5) { const bf16_t* p = (const bf16_t*)(ws + WS_MRG); v = __uint_as_float((unsigned)p[i] << 16); }
                if (DBG_SRC == 6) { const bf16_t* p = (const bf16_t*)(ws + WS_HID); v = __uint_as_float((unsigned)p[i] << 16) + __uint_as_float((unsigned)p[i + (size_t)MTOK * DM] << 16); }
                if (DBG_SRC == 7) { const float* p = (const float*)(ws + WS_OH); v = p[i] + p[i + (size_t)MTOK * DM]; }
                out[i] = v; } }
    } else
    if (IN(29)) {
        PH_ARGS();
        const int tid = TID_OF(wv), lane = tid & 63, wid = wv, gw = bid_ * 8 + wid, NGW = G_ * 8; (void)tid;
        const float* SSQ = (const float*)(ws + WS_SSQ); const float* X = (const float*)(ws + WS_X); const float* nf = ap->norm_final; float* out = ap->out;
        for (int m = gw; m < MTOK; m += NGW) { const float rs = row_rstd(SSQ, m);
            const f32x4* xr = (const f32x4*)(X + (size_t)m * DM) + lane; const f32x4* gr = (const f32x4*)nf + lane; f32x4* orow = (f32x4*)(out + (size_t)m * DM) + lane;
#pragma unroll
            for (int j = 0; j < 8; ++j) orow[64 * j] = xr[64 * j] * rs * gr[64 * j]; }
    }
#undef IN
#undef GRID_BAR
}

extern "C" void kernel_launch(void* const* d_in, const int* in_sizes, int n_in, void* d_out, int out_size, void* d_ws, size_t ws_size, hipStream_t stream) {
    static int grid = 0;
    if (grid == 0) {
        if (n_in != 17 || out_size != MTOK * DM || ws_size < WS_END) { fprintf(stderr, "kernel_launch: unexpected shapes (n_in %d, out %d, ws %zu < %zu); nothing launched\n", n_in, out_size, ws_size, (size_t)WS_END); grid = -1; return; }
        int dev = 0, cus = 0;
        if (hipGetDevice(&dev) != hipSuccess || hipDeviceGetAttribute(&cus, hipDeviceAttributeMultiprocessorCount, dev) != hipSuccess) { grid = -1; return; }
        if (hipFuncSetAttribute((const void*)mk_fwd, hipFuncAttributeMaxDynamicSharedMemorySize, LDS_BYTES) != hipSuccess) { fprintf(stderr, "kernel_launch: hipFuncSetAttribute failed\n"); grid = -1; return; }
        int per_cu = 0;
        if (hipOccupancyMaxActiveBlocksPerMultiprocessor(&per_cu, (const void*)mk_fwd, 512, LDS_BYTES) != hipSuccess || per_cu < 1) fprintf(stderr, "kernel_launch: occupancy query says %d\n", per_cu);
        (void)hipGetLastError();
        grid = cus;
    }
    if (grid < 0) return;
    (void)hipMemsetAsync((char*)d_ws + WS_CTL, 0, CTL_ZERO_BYTES, stream);
    Args a{};
    a.x = (const float*)d_in[0]; a.pos = (const int*)d_in[1]; a.norm_attn = (const float*)d_in[2]; a.w_in = (const float*)d_in[3]; a.gate_b = (const float*)d_in[4]; a.lam = (const float*)d_in[5];
    a.subln = (const float*)d_in[6]; a.sgu_ln_g = (const float*)d_in[7]; a.sgu_ln_b = (const float*)d_in[8]; a.w_spatial = (const float*)d_in[9]; a.b_spatial = (const float*)d_in[10];
    a.w_branch = (const float*)d_in[11]; a.w_out = (const float*)d_in[12]; a.norm_ffn = (const float*)d_in[13]; a.w_ffn_in = (const float*)d_in[14]; a.w_ffn_out = (const float*)d_in[15]; a.norm_final = (const float*)d_in[16];
    a.out = (float*)d_out; a.ws = (unsigned char*)d_ws;
#if MK_MULTI
    for (int p = 0; p < 30; ++p) { a.ph_lo = p; a.ph_hi = p + 1; hipLaunchKernelGGL(mk_fwd, dim3(grid), dim3(512), LDS_BYTES, stream, a); }
#else
    a.ph_lo = 0; a.ph_hi = 30;
    hipLaunchKernelGGL(mk_fwd, dim3(grid), dim3(512), LDS_BYTES, stream, a);
#endif
}
```

```cpp
#include <hip/hip_runtime.h>
#include <hip/hip_bf16.h>
#include <cstdio>
#include <cstdint>

#ifndef MK_MULTI
#define MK_MULTI 0
#endif

#ifndef DBG_CUT
#define DBG_CUT 0
#endif
#ifndef REP_P6_SKIPEPI
#define REP_P6_SKIPEPI 0
#endif
#ifndef ATT_ROT
#define ATT_ROT 1
#endif
#ifndef ATT_PROBE
#define ATT_PROBE 0
#endif
#ifndef LOOSE_RESTART
#define LOOSE_RESTART 1
#endif
#ifndef REP_P0
#define REP_P0 1
#endif
#ifndef REP_ATT
#define REP_ATT 1
#endif
#ifndef REP_P1
#define REP_P1 1
#endif
#ifndef REP_P3
#define REP_P3 1
#endif
#ifndef REP_P4
#define REP_P4 1
#endif
#ifndef REP_P6
#define REP_P6 1
#endif
#ifndef REP_SGU
#define REP_SGU 1
#endif
#ifndef DBG_ROT
#define DBG_ROT 0
#endif
#ifndef DBG_SRC
#define DBG_SRC 0
#endif
#ifndef EN_P0
#define EN_P0 1
#endif
#ifndef EN_P1
#define EN_P1 1
#endif
#ifndef EN_ATT
#define EN_ATT 1
#endif
#ifndef EN_SGU
#define EN_SGU 1
#endif
#ifndef EN_P3
#define EN_P3 1
#endif
#ifndef EN_P4
#define EN_P4 1
#endif
#ifndef EN_P5
#define EN_P5 1
#endif
#ifndef EN_P6
#define EN_P6 1
#endif
#ifndef EN_P7
#define EN_P7 1
#endif
#define LAS __attribute__((address_space(3)))
#define GAS __attribute__((address_space(1)))
typedef unsigned short bf16_t;
typedef short bf16x8 __attribute__((ext_vector_type(8)));
typedef short s16x4 __attribute__((ext_vector_type(4)));
typedef float f32x2 __attribute__((ext_vector_type(2)));
typedef float f32x4 __attribute__((ext_vector_type(4)));
typedef float f32x16 __attribute__((ext_vector_type(16)));
typedef unsigned u32x2 __attribute__((ext_vector_type(2)));
typedef unsigned u32x4 __attribute__((ext_vector_type(4)));

constexpr int DM = 2048, NBATCH = 4, SEQ = 4096, DEPTH = 4, MTOK = NBATCH * SEQ;
constexpr int NHEAD = 8, HDIM = 128, INCOLS = 14336, FFH = 5632, KBR = 4096;
constexpr float EPS = 1e-6f;

constexpr size_t WS_CTL = 0, CTL_ZERO_BYTES = 32768;
constexpr size_t SZ_WIN = (size_t)INCOLS * DM * 2, SZ_WBR = (size_t)DM * KBR * 2, SZ_WOUT = (size_t)DM * DM * 2, SZ_WFI = (size_t)2 * FFH * DM * 2, SZ_WFO = (size_t)DM * FFH * 2;
constexpr size_t WS_WIN = 1u << 20;
constexpr size_t WS_WBR = WS_WIN + DEPTH * SZ_WIN;
constexpr size_t WS_WOUT = WS_WBR + DEPTH * SZ_WBR;
constexpr size_t WS_WFI = WS_WOUT + DEPTH * SZ_WOUT;
constexpr size_t WS_WFO = WS_WFI + DEPTH * SZ_WFI;
constexpr size_t WS_WST = WS_WFO + DEPTH * SZ_WFO;
constexpr size_t WS_COS = WS_WST + (size_t)DEPTH * 8 * 128 * 128 * 2;
constexpr size_t WS_SIN = WS_COS + (size_t)MTOK * 64 * 2;
constexpr size_t WS_X = WS_SIN + (size_t)MTOK * 64 * 2;
constexpr size_t WS_XB = WS_X + (size_t)MTOK * DM * 4;
constexpr size_t WS_SSQ = WS_XB + (size_t)MTOK * DM * 2;
constexpr size_t WS_LNST = WS_SSQ + (size_t)MTOK * 8 * 4;
constexpr size_t WS_QH = WS_LNST + (size_t)MTOK * 16 * 4;
constexpr size_t WS_KH = WS_QH + (size_t)MTOK * DM * 2;
constexpr size_t WS_VH = WS_KH + (size_t)MTOK * DM * 2;
constexpr size_t WS_HID = WS_QH;
constexpr size_t WS_U = WS_VH + (size_t)MTOK * DM * 2;
constexpr size_t WS_MRG = WS_U;
constexpr size_t WS_GV = WS_U + (size_t)MTOK * DM * 2;
constexpr size_t WS_GA = WS_GV + (size_t)MTOK * DM * 2;
constexpr size_t WS_GS = WS_GA + (size_t)MTOK * DM * 2;
constexpr size_t WS_OH = WS_GS + (size_t)MTOK * DM * 2;
constexpr size_t WS_A2 = WS_OH + (size_t)MTOK * DM * 2 * 4;
constexpr size_t WS_END = WS_A2 + (size_t)MTOK * KBR * 2;
static_assert((size_t)MTOK * FFH * 2 <= 3 * (size_t)MTOK * DM * 2, "hidden overlays q|k|v");
constexpr int CW_BAR = 4096;

constexpr int RING_BYTES = 131072;
constexpr int XS_OFF = RING_BYTES;
constexpr int RS_OFF = XS_OFF + 8192;
constexpr int MISC_OFF = RS_OFF + 1024;
constexpr int LDS_BYTES = 147456;

typedef __bf16 bf16x2_t __attribute__((ext_vector_type(2)));
__device__ __forceinline__ unsigned cvt_pk_bf16(float lo, float hi) { f32x2 v = {lo, hi}; bf16x2_t b = __builtin_convertvector(v, bf16x2_t); return __builtin_bit_cast(unsigned, b); }
__device__ __forceinline__ float bf_lo(unsigned w) { return __uint_as_float(w << 16); }
__device__ __forceinline__ float bf_hi(unsigned w) { return __uint_as_float(w & 0xffff0000u); }
__device__ __forceinline__ int lane_id() { int r; asm volatile("v_mbcnt_lo_u32_b32 %0, -1, 0\n\tv_mbcnt_hi_u32_b32 %0, -1, %0" : "=v"(r)); return r; }
#define TID_OF(wv) (((wv) << 6) | lane_id())
__device__ __forceinline__ float wave_sum(float v, int lane) {
#pragma unroll
    for (int o = 1; o < 64; o <<= 1) v += __uint_as_float((unsigned)__builtin_amdgcn_ds_bpermute((lane ^ o) << 2, (int)__float_as_uint(v)));
    return v;
}
__device__ __forceinline__ float sum_x16_x32(float v) {
    { auto r = __builtin_amdgcn_permlane16_swap(__float_as_uint(v), __float_as_uint(v), false, false); v = __uint_as_float(r[0]) + __uint_as_float(r[1]); }
    { auto r = __builtin_amdgcn_permlane32_swap(__float_as_uint(v), __float_as_uint(v), false, false); v = __uint_as_float(r[0]) + __uint_as_float(r[1]); }
    return v;
}
__device__ __forceinline__ float sigmoidf_(float x) { return __builtin_amdgcn_rcpf(1.0f + __builtin_amdgcn_exp2f(-1.4426950408889634f * x)); }
__device__ __forceinline__ f32x2 gelu_pk(f32x2 v) {
    const f32x2 av = __builtin_elementwise_abs(v), d = av * 0.2316418882f + 1.0f;
    f32x2 t; t.x = __builtin_amdgcn_rcpf(d.x); t.y = __builtin_amdgcn_rcpf(d.y);
    f32x2 q = t * 0.5307027145f + (-0.7265760135f); q = q * t + 0.7107068705f; q = q * t + (-0.142248368f); q = q * t + 0.127414796f; q = q * t;
    const f32x2 s = (v * v) * (-0.72134752044f);
    f32x2 e; e.x = __builtin_amdgcn_exp2f(s.x); e.y = __builtin_amdgcn_exp2f(s.y);
    const f32x2 m = v * (q * e), r = v - m;
    f32x2 o; o.x = v.x < 0.f ? m.x : r.x; o.y = v.y < 0.f ? m.y : r.y; return o;
}
__device__ __forceinline__ f32x4 gelu4(f32x4 v) { const f32x2 a = gelu_pk((f32x2){v[0], v[1]}), b = gelu_pk((f32x2){v[2], v[3]}); return (f32x4){a.x, a.y, b.x, b.y}; }
__device__ __forceinline__ void gelu8(f32x4 (&g)[2], f32x2& s1, f32x2& s2) {
    f32x2 v[4], t[4], q[4], e[4];
#pragma unroll
    for (int i = 0; i < 4; ++i) v[i] = (f32x2){g[i >> 1][(i & 1) * 2], g[i >> 1][(i & 1) * 2 + 1]};
#pragma unroll
    for (int i = 0; i < 4; ++i) { const f32x2 d = __builtin_elementwise_abs(v[i]) * 0.2316418882f + 1.0f; t[i].x = __builtin_amdgcn_rcpf(d.x); t[i].y = __builtin_amdgcn_rcpf(d.y); }
    __builtin_amdgcn_sched_barrier(0);
#pragma unroll
    for (int i = 0; i < 4; ++i) { const f32x2 s = (v[i] * v[i]) * (-0.72134752044f); e[i].x = __builtin_amdgcn_exp2f(s.x); e[i].y = __builtin_amdgcn_exp2f(s.y); }
    __builtin_amdgcn_sched_barrier(0);
#pragma unroll
    for (int i = 0; i < 4; ++i) q[i] = t[i] * 0.5307027145f + (-0.7265760135f);
    __builtin_amdgcn_sched_barrier(0);
#pragma unroll
    for (int i = 0; i < 4; ++i) q[i] = q[i] * t[i] + 0.7107068705f;
    __builtin_amdgcn_sched_barrier(0);
#pragma unroll
    for (int i = 0; i < 4; ++i) q[i] = q[i] * t[i] + (-0.142248368f);
    __builtin_amdgcn_sched_barrier(0);
#pragma unroll
    for (int i = 0; i < 4; ++i) q[i] = q[i] * t[i] + 0.127414796f;
    __builtin_amdgcn_sched_barrier(0);
#pragma unroll
    for (int i = 0; i < 4; ++i) q[i] = (q[i] * t[i]) * e[i];
    __builtin_amdgcn_sched_barrier(0);
#pragma unroll
    for (int i = 0; i < 4; ++i) { f32x2 mx; mx.x = fmaxf(v[i].x, 0.f); mx.y = fmaxf(v[i].y, 0.f); const f32x2 o = mx - __builtin_elementwise_abs(v[i]) * q[i];
        s1 += o; s2 += o * o; g[i >> 1][(i & 1) * 2] = o.x; g[i >> 1][(i & 1) * 2 + 1] = o.y; }
}
__device__ __forceinline__ u32x4 pack8(f32x4 a, f32x4 b) { u32x4 w; w.x = cvt_pk_bf16(a[0], a[1]); w.y = cvt_pk_bf16(a[2], a[3]); w.z = cvt_pk_bf16(b[0], b[1]); w.w = cvt_pk_bf16(b[2], b[3]); return w; }

namespace pg8 {
constexpr int BM = 256, BK = 64, HALF = 128, HTB = HALF * BK * 2, STAGE_BYTES = 8 * HTB, NXCD = 8, WGM = 8;
__host__ __device__ __forceinline__ int lds_byte(int r, int c) { const int st = (r >> 4) * 2 + (c >> 5), rr = r & 15, cc = c & 31, ob = rr * 64 + cc * 2; return st * 1024 + (ob ^ (((ob >> 9) & 1) << 5)); }
__host__ __device__ __forceinline__ void stage_rc(int b, int& R, int& C) { const int st = b / 1024, sb = b % 1024, swz = sb ^ (((sb >> 9) & 1) << 5); R = (st >> 1) * 16 + swz / 64; C = (st & 1) * 32 + (swz % 64) / 2; }
__host__ __device__ __forceinline__ int perm32(int rho) { const int n = rho >> 4, i = rho & 15; return 8 * (i >> 2) + 4 * n + (i & 3); }
struct Unit { int pm, pn; };
struct Gemm { const bf16_t* A; const bf16_t* Bt; int M, N, K; };
struct StaticOrder {
    int nM, nN, nwg, G, c, rot;
    __host__ __device__ void init(int M, int N, int G_, int c_, int rot_ = 0) { nM = M / BM; nN = N / BM; nwg = nM * nN; G = G_; c = c_; rot = rot_; }
    __host__ __device__ bool next(int i, Unit& u) const {
        if (G == 256 && nM == 64 && rot == 0 && (nN & 3) == 0) { const int pn = 4 * i + (c >> 6); if (pn >= nN) return false; u.pm = 8 * (c & 7) + ((c >> 3) & 7); u.pn = pn; return true; }
        const long L = (long)i * G + c; if (L >= nwg) return false;
        int wgid = (int)L; { const int q = nwg / NXCD, r = nwg % NXCD, xcd = wgid % NXCD, off = wgid / NXCD; wgid = (xcd < r ? xcd * (q + 1) : r * (q + 1) + (xcd - r) * q) + off; }
        const int nig = WGM * nN, gid = wgid / nig, fm = gid * WGM, gsz = (nM - fm) < WGM ? (nM - fm) : WGM;
        u.pm = fm + ((wgid % nig) % gsz); u.pn = ((wgid % nig) / gsz + rot) % nN; return true;
    }
};
template <class Epi>
__device__ __forceinline__ void gemm_phase(LAS unsigned char* lds, const Gemm g, const StaticOrder& S, const Epi& E, const int wv) {
    int tid_ = TID_OF(wv); asm volatile("" : "+v"(tid_));
    const int tid = tid_, wid = __builtin_amdgcn_readfirstlane(tid >> 6), lane = tid & 63, wr = wid >> 2, wc = wid & 3, fr = lane & 15, fq = lane >> 4;
    const int K = g.K, nt = K / BK;
    unsigned voffA[2], voffB[2];
#pragma unroll
    for (int i = 0; i < 2; ++i) { int R, C; stage_rc(tid * 16 + i * 8192, R, C); const int Rb = (R & ~31) + perm32(R & 31);
        voffA[i] = (unsigned)(R * K + C) * 2u; voffB[i] = (unsigned)(Rb * K + C) * 2u; }
    const size_t kstep = (size_t)(BK * 2);
    const size_t hstep = (size_t)HALF * K * 2;
    const size_t tstep = 2 * hstep;
    const unsigned ldsw = (unsigned)wid * 1024u;
    const int aoff = lds_byte(wr * 64 + fr, fq * 8), boff = lds_byte(wc * 32 + fr, fq * 8);
#define PG8_SA(b, h) (((b) * 2 + (h)) * HTB)
#define PG8_SB(b, h) ((4 + (b) * 2 + (h)) * HTB)
#define PG8_STAGE(bufoff, gbase, voff) do { _Pragma("unroll") for (int _i = 0; _i < 2; ++_i) { unsigned _vo = (voff)[_i]; asm volatile("" : "+v"(_vo)); \
        __builtin_amdgcn_global_load_lds((const unsigned*)((const char*)(gbase) + _vo), (LAS unsigned*)(lds + (bufoff) + ldsw + _i * 8192), 16, 0, 0); } } while (0)
#define PG8_LDA(dst, b, h) do { _Pragma("unroll") for (int m = 0; m < 4; ++m) _Pragma("unroll") for (int k = 0; k < 2; ++k) dst[m][k] = *(const LAS bf16x8*)(lds + PG8_SA(b, h) + aoff + m * 2048 + k * 1024); } while (0)
#define PG8_LDB(dst, b, h) do { _Pragma("unroll") for (int n = 0; n < 2; ++n) _Pragma("unroll") for (int k = 0; k < 2; ++k) dst[n][k] = *(const LAS bf16x8*)(lds + PG8_SB(b, h) + boff + n * 2048 + k * 1024); } while (0)
#define PG8_MMA(ai, bj, At, Bt) do { __builtin_amdgcn_s_setprio(1); _Pragma("unroll") for (int m = 0; m < 4; ++m) _Pragma("unroll") for (int n = 0; n < 2; ++n) _Pragma("unroll") for (int k = 0; k < 2; ++k) \
        acc[ai][bj][m][n] = __builtin_amdgcn_mfma_f32_16x16x32_bf16(Bt[n][k], At[m][k], acc[ai][bj][m][n], 0, 0, 0); __builtin_amdgcn_s_setprio(0); } while (0)
#define PG8_MMA0(ai, bj, At, Bt) do { __builtin_amdgcn_s_setprio(1); _Pragma("unroll") for (int m = 0; m < 4; ++m) _Pragma("unroll") for (int n = 0; n < 2; ++n) { \
        acc[ai][bj][m][n] = __builtin_amdgcn_mfma_f32_16x16x32_bf16(Bt[n][0], At[m][0], (f32x4){0.f, 0.f, 0.f, 0.f}, 0, 0, 0); \
        acc[ai][bj][m][n] = __builtin_amdgcn_mfma_f32_16x16x32_bf16(Bt[n][1], At[m][1], acc[ai][bj][m][n], 0, 0, 0); } __builtin_amdgcn_s_setprio(0); } while (0)
#define PG8_WAIT_V(n) asm volatile("s_waitcnt vmcnt(" #n ")" ::: "memory")
#define PG8_WAIT_L(n) asm volatile("s_waitcnt lgkmcnt(" #n ")" ::: "memory")
#define PG8_BAR __builtin_amdgcn_s_barrier()
#define PG8_SCHED __builtin_amdgcn_sched_barrier(0)
    Unit cur, nxt; int ui = 0;
    if (!S.next(0, cur)) return;
    f32x4 acc[2][2][4][2];
    bf16x8 At[4][2], B0[2][2], B1[2][2];
    const char* cA = (const char*)g.A + (size_t)cur.pm * tstep; const char* cB = (const char*)g.Bt + (size_t)cur.pn * tstep;
    PG8_STAGE(PG8_SB(0, 0), cB, voffB); PG8_STAGE(PG8_SB(0, 1), cB + hstep, voffB); PG8_STAGE(PG8_SA(0, 0), cA, voffA); PG8_STAGE(PG8_SA(0, 1), cA + hstep, voffA);
    if (wr == 1) PG8_BAR;
    PG8_WAIT_V(2); PG8_BAR;
    PG8_STAGE(PG8_SB(1, 0), cB + kstep, voffB); PG8_STAGE(PG8_SA(1, 0), cA + kstep, voffA); PG8_STAGE(PG8_SB(1, 1), cB + hstep + kstep, voffB);
    PG8_WAIT_V(6); PG8_BAR;
    for (;;) {
        const bool has_next = S.next(ui + 1, nxt);
        const char* nA = has_next ? (const char*)g.A + (size_t)nxt.pm * tstep : cA; const char* nB = has_next ? (const char*)g.Bt + (size_t)nxt.pn * tstep : cB;
#define K_BODY(t, MMAF, MIDCHK, W12) do { \
            if constexpr (Epi::MID && MIDCHK) { if ((t) == (nt >> 1)) E.mid(acc, cur, wr, wc, fr, fq); } \
            const bool last = ((t) == nt - 2); \
            const char* a1 = cA + (size_t)((t) + 1) * kstep; \
            const char* a2 = last ? nA : cA + (size_t)((t) + 2) * kstep; const char* b2 = last ? nB : cB + (size_t)((t) + 2) * kstep; \
            const char* a3 = a2 + kstep; const char* b3 = b2 + kstep; \
            PG8_LDB(B0, 0, 0); PG8_LDB(B1, 0, 1); PG8_SCHED; PG8_LDA(At, 0, 0); PG8_STAGE(PG8_SA(1, 1), a1 + hstep, voffA); \
            W12; PG8_WAIT_L(0); PG8_BAR; MMAF(0, 0, At, B0); MMAF(0, 1, At, B1); PG8_BAR; PG8_SCHED; \
            PG8_LDA(At, 0, 1); PG8_STAGE(PG8_SB(0, 0), b2, voffB); PG8_STAGE(PG8_SB(0, 1), b2 + hstep, voffB); PG8_STAGE(PG8_SA(0, 0), a2, voffA); \
            W12; PG8_WAIT_L(0); PG8_BAR; MMAF(1, 0, At, B0); MMAF(1, 1, At, B1); PG8_BAR; PG8_SCHED; \
            PG8_LDB(B0, 1, 0); PG8_LDB(B1, 1, 1); PG8_SCHED; PG8_LDA(At, 1, 0); PG8_STAGE(PG8_SA(0, 1), a2 + hstep, voffA); \
            PG8_WAIT_V(8); PG8_WAIT_L(0); PG8_BAR; PG8_MMA(0, 0, At, B0); PG8_MMA(0, 1, At, B1); PG8_BAR; PG8_SCHED; \
            PG8_LDA(At, 1, 1); PG8_STAGE(PG8_SB(1, 0), b3, voffB); PG8_STAGE(PG8_SB(1, 1), b3 + hstep, voffB); PG8_STAGE(PG8_SA(1, 0), a3, voffA); \
            PG8_WAIT_V(8); PG8_WAIT_L(0); PG8_BAR; PG8_MMA(1, 0, At, B0); PG8_MMA(1, 1, At, B1); PG8_BAR; PG8_SCHED; \
        } while (0)
#define PG8_WAIT_FIRST() do { if (LOOSE_RESTART && ui > 0) { if constexpr (Epi::NVM >= 32) asm volatile("s_waitcnt vmcnt(40)" ::: "memory"); else if constexpr (Epi::NVM >= 16) asm volatile("s_waitcnt vmcnt(24)" ::: "memory"); \
            else if constexpr (Epi::NVM >= 8) asm volatile("s_waitcnt vmcnt(16)" ::: "memory"); else asm volatile("s_waitcnt vmcnt(8)" ::: "memory"); } else asm volatile("s_waitcnt vmcnt(8)" ::: "memory"); } while (0)
        K_BODY(0, PG8_MMA0, false, PG8_WAIT_FIRST());
        for (int t = 2; t < nt; t += 2) K_BODY(t, PG8_MMA, true, PG8_WAIT_V(8));
#undef PG8_WAIT_FIRST
#undef K_BODY
        if (wr == 0) PG8_BAR;
        { const int lane_ = lane_id();
          E(acc, cur, wr, wc, lane_ & 15, lane_ >> 4); }
        if (!has_next) break;
        cur = nxt; cA = nA; cB = nB; ++ui;
        if (wr == 1) PG8_BAR;
    }
    PG8_WAIT_V(0);
    PG8_BAR;
#undef PG8_SA
#undef PG8_SB
#undef PG8_STAGE
#undef PG8_LDA
#undef PG8_LDB
#undef PG8_MMA
#undef PG8_WAIT_V
#undef PG8_WAIT_L
#undef PG8_BAR
#undef PG8_SCHED
}
}

struct Args {
    const float* x; const int* pos; const float* norm_attn; const float* w_in; const float* gate_b; const float* lam; const float* subln; const float* sgu_ln_g; const float* sgu_ln_b;
    const float* w_spatial; const float* b_spatial; const float* w_branch; const float* w_out; const float* norm_ffn; const float* w_ffn_in; const float* w_ffn_out; const float* norm_final;
    float* out; unsigned char* ws; int ph_lo, ph_hi;
};

typedef const __attribute__((address_space(4))) Args* ArgP;
__device__ __forceinline__ ArgP get_args() { ArgP p = (ArgP)__builtin_amdgcn_kernarg_segment_ptr(); asm volatile("" : "+s"(p)); return p; }
template <class T> __device__ __forceinline__ T* as_global(T* p) { return (T*)(GAS T*)p; }
__device__ __forceinline__ unsigned char* launder(unsigned char* p) { asm volatile("" : "+s"(p)); return as_global(p); }
extern __shared__ __attribute__((aligned(16))) unsigned char lds_raw[];
__device__ __forceinline__ LAS unsigned char* lds_base() { return (LAS unsigned char*)lds_raw; }

typedef f32x4 AccT[2][2][4][2];
#define EPI_BAR() do { asm volatile("s_waitcnt lgkmcnt(0)" ::: "memory"); __builtin_amdgcn_s_barrier(); asm volatile("" ::: "memory"); } while (0)
typedef _Float16 h16x2 __attribute__((ext_vector_type(2)));
__device__ __forceinline__ float row_rstd(const float* ssq, int row) {
    const f32x4 a = *(const f32x4*)(ssq + (size_t)row * 8), b = *(const f32x4*)(ssq + (size_t)row * 8 + 4);
    const float s = ((a[0] + a[1]) + (a[2] + a[3])) + ((b[0] + b[1]) + (b[2] + b[3]));
    return __builtin_amdgcn_rsqf(s * (1.0f / DM) + EPS);
}
__device__ __forceinline__ void panel_rstd_to_lds(const float* ssq, int pm, int tid) { if (tid < 256) ((LAS float*)(lds_base() + RS_OFF))[tid] = row_rstd(ssq, pm * 256 + tid); }
__device__ __forceinline__ void load_rstd(float (&rs)[8], const float* ssq, int pm, int pm0, int rl0) {
    const LAS float* rsl = (const LAS float*)(lds_base() + RS_OFF);
#pragma unroll
    for (int i = 0; i < 8; ++i) rs[i] = 0.f;
    if (pm == pm0) {
#pragma unroll
        for (int i = 0; i < 8; ++i) rs[i] = rsl[rl0 + (i >> 2) * 128 + (i & 3) * 16];
    } else {
#pragma unroll
        for (int i = 0; i < 8; ++i) rs[i] = row_rstd(ssq, pm * 256 + rl0 + (i >> 2) * 128 + (i & 3) * 16);
    }
}

struct EpiIn {
    static constexpr bool MID = false; static constexpr int NVM = 16;
    int l, pm0;
    __device__ __forceinline__ void operator()(const AccT& acc, const pg8::Unit& u, int wr, int wc, int fr, int fq) const {
        unsigned char* ws = get_args()->ws;
        const int pn = u.pn, rl0 = wr * 64 + fr, rowu = u.pm * 256 + wr * 64;
        float rs[8]; load_rstd(rs, (const float*)(ws + WS_SSQ), u.pm, pm0, rl0);
        if (pn < 16) {
            bf16_t* dst = (bf16_t*)(ws + (pn < 8 ? WS_QH : WS_KH)); const int h = pn & 7, c = wc >> 1; const unsigned d0 = 32 * (wc & 1) + 8 * fq;
            const _Float16* cosT = (const _Float16*)(ws + WS_COS) + (size_t)rowu * 64; const _Float16* sinT = (const _Float16*)(ws + WS_SIN) + (size_t)rowu * 64;
            const unsigned lt = (unsigned)fr * 64u + d0;
            const int bb = rowu >> 12, su = rowu & 4095;
            bf16_t* dsth = dst + ((size_t)(((bb * NHEAD + h) * 2 + c) * SEQ + su)) * HDIM; const unsigned lo = (unsigned)fr * HDIM + d0;
#pragma unroll
            for (int ai = 0; ai < 2; ++ai) {
                u32x4 cw[4], sw[4];
#pragma unroll
                for (int m = 0; m < 4; ++m) { const int ro = (ai * 128 + m * 16) * 64; cw[m] = *(const u32x4*)(cosT + ro + lt); sw[m] = *(const u32x4*)(sinT + ro + lt); }
#pragma unroll
                for (int m = 0; m < 4; ++m) {
                    const float r = rs[ai * 4 + m];
                    f32x4 c0, c1, s0, s1;
#pragma unroll
                    for (int q = 0; q < 2; ++q) { const unsigned wca = cw[m][q], wcb = cw[m][q + 2], wsa = sw[m][q], wsb = sw[m][q + 2];
                        const h16x2 ca = __builtin_bit_cast(h16x2, wca), cb = __builtin_bit_cast(h16x2, wcb), sa = __builtin_bit_cast(h16x2, wsa), sb = __builtin_bit_cast(h16x2, wsb);
                        c0[2 * q] = (float)ca[0]; c0[2 * q + 1] = (float)ca[1]; c1[2 * q] = (float)cb[0]; c1[2 * q + 1] = (float)cb[1];
                        s0[2 * q] = (float)sa[0]; s0[2 * q + 1] = (float)sa[1]; s1[2 * q] = (float)sb[0]; s1[2 * q + 1] = (float)sb[1]; }
                    const f32x4 l0 = acc[ai][0][m][0] * r, l1 = acc[ai][0][m][1] * r, h0 = acc[ai][1][m][0] * r, h1 = acc[ai][1][m][1] * r;
                    const f32x4 ol0 = l0 * c0 - h0 * s0, ol1 = l1 * c1 - h1 * s1, oh0 = h0 * c0 + l0 * s0, oh1 = h1 * c1 + l1 * s1;
                    bf16_t* p = dsth + (ai * 128 + m * 16) * HDIM;
                    *(u32x4*)(p + lo) = pack8(ol0, ol1); *(u32x4*)(p + 64 + lo) = pack8(oh0, oh1);
                } }
        } else if (pn < 24) {
            const int h = pn - 16, bb = rowu >> 12, su = rowu & 4095; const unsigned lo = (unsigned)fr * HDIM + 32 * wc + 8 * fq;
#pragma unroll
            for (int bj = 0; bj < 2; ++bj) { bf16_t* vb = (bf16_t*)(ws + WS_VH) + ((size_t)(((bb * NHEAD + h) * 2 + bj) * SEQ + su)) * HDIM;
#pragma unroll
                for (int ai = 0; ai < 2; ++ai)
#pragma unroll
                    for (int m = 0; m < 4; ++m) { const float r = rs[ai * 4 + m]; *(u32x4*)(vb + (ai * 128 + m * 16) * HDIM + lo) = pack8(acc[ai][bj][m][0] * r, acc[ai][bj][m][1] * r); } }
        } else if (pn < 32) {
            bf16_t* dst = (bf16_t*)(ws + WS_U) + (size_t)rowu * DM + 256 * (pn - 24); const unsigned lo = (unsigned)fr * DM + 32 * wc + 8 * fq;
#pragma unroll
            for (int ai = 0; ai < 2; ++ai)
#pragma unroll
                for (int m = 0; m < 4; ++m) { const float r = rs[ai * 4 + m];
#pragma unroll
                    for (int bj = 0; bj < 2; ++bj) *(u32x4*)(dst + (ai * 128 + m * 16) * DM + bj * 128 + lo) = pack8(acc[ai][bj][m][0] * r, acc[ai][bj][m][1] * r); }
        } else if (pn < 40) {
            bf16_t* dst = (bf16_t*)(ws + WS_GV) + (size_t)rowu * DM + 256 * (pn - 32); const unsigned lo = (unsigned)fr * DM + 32 * wc + 8 * fq;
            LAS f32x2* xs = (LAS f32x2*)(lds_base() + XS_OFF);
#pragma unroll
            for (int ai = 0; ai < 2; ++ai)
#pragma unroll
                for (int m = 0; m < 4; ++m) {
                    const float r = rs[ai * 4 + m];
                    f32x2 a1 = {0.f, 0.f}, a2 = {0.f, 0.f};
#pragma unroll
                    for (int bj = 0; bj < 2; ++bj) { f32x4 g[2] = {acc[ai][bj][m][0] * r, acc[ai][bj][m][1] * r};
                        gelu8(g, a1, a2);
                        *(u32x4*)(dst + (ai * 128 + m * 16) * DM + bj * 128 + lo) = pack8(g[0], g[1]); }
                    const float s1 = sum_x16_x32(a1.x + a1.y), s2 = sum_x16_x32(a2.x + a2.y);
                    if (fq == 0) xs[(rl0 + ai * 128 + m * 16) * 4 + wc] = (f32x2){s1, s2};
                }
            EPI_BAR();
            { float* lnst = (float*)(ws + WS_LNST);
                const int t = 64 * (4 * wr + wc) + lane_id();
                if (t < 256) { const f32x2 a = xs[t * 4 + 0], b = xs[t * 4 + 1], c = xs[t * 4 + 2], d = xs[t * 4 + 3];
                    *(f32x2*)(lnst + (size_t)(u.pm * 256 + t) * 16 + 2 * (pn - 32)) = (f32x2){(a.x + b.x) + (c.x + d.x), (a.y + b.y) + (c.y + d.y)}; } }
            EPI_BAR();
        } else {
            const int ch0 = 128 * (pn - 40); bf16_t* dR = (bf16_t*)(ws + WS_GA) + (size_t)rowu * DM + ch0; bf16_t* dS = (bf16_t*)(ws + WS_GS) + (size_t)rowu * DM + ch0; const unsigned lo = (unsigned)fr * DM + 32 * wc + 8 * fq;
            const float* gb = get_args()->gate_b + l * 2 * DM + ch0; const unsigned lc = 32 * wc + 8 * fq;
            f32x4 bv[2][2];
#pragma unroll
            for (int bj = 0; bj < 2; ++bj)
#pragma unroll
                for (int n = 0; n < 2; ++n) bv[bj][n] = *(const f32x4*)(gb + bj * DM + 4 * n + lc) * (-1.4426950408889634f);
#pragma unroll
            for (int ai = 0; ai < 2; ++ai)
#pragma unroll
                for (int m = 0; m < 4; ++m) {
                    const float r = rs[ai * 4 + m] * (-1.4426950408889634f);
                    f32x4 rr[2], gg[2];
#pragma unroll
                    for (int n = 0; n < 2; ++n) { const f32x4 xa = acc[ai][0][m][n] * r + bv[0][n], xs_ = acc[ai][1][m][n] * r + bv[1][n];
#pragma unroll
                        for (int h = 0; h < 2; ++h) { f32x2 ea, ds;
                            ea.x = __builtin_amdgcn_exp2f(xa[2 * h]); ea.y = __builtin_amdgcn_exp2f(xa[2 * h + 1]);
                            ds.x = __builtin_amdgcn_exp2f(fminf(xs_[2 * h], 100.f)); ds.y = __builtin_amdgcn_exp2f(fminf(xs_[2 * h + 1], 100.f));
                            ea = ea + 1.0f; ds = ds + 1.0f;
                            f32x2 ra, rd; ra.x = __builtin_amdgcn_rcpf(ea.x); ra.y = __builtin_amdgcn_rcpf(ea.y); rd.x = __builtin_amdgcn_rcpf(ds.x); rd.y = __builtin_amdgcn_rcpf(ds.y);
                            const f32x2 rt = ds * ra; gg[n][2 * h] = rd.x; gg[n][2 * h + 1] = rd.y; rr[n][2 * h] = rt.x; rr[n][2 * h + 1] = rt.y; } }
                    *(u32x4*)(dR + (ai * 128 + m * 16) * DM + lo) = pack8(rr[0], rr[1]); *(u32x4*)(dS + (ai * 128 + m * 16) * DM + lo) = pack8(gg[0], gg[1]);
                }
        }
    }
};

struct EpiBranch {
    static constexpr bool MID = true; static constexpr int NVM = 32;
    __device__ __forceinline__ void mid(AccT& acc, const pg8::Unit& u, int wr, int wc, int fr, int fq) const {
        unsigned char* ws = get_args()->ws; const size_t uo = (size_t)(u.pm * 256 + wr * 64) * DM + u.pn * 256; const unsigned lo = (unsigned)fr * DM + 32 * wc + 8 * fq;
        const bf16_t* GA = (const bf16_t*)(ws + WS_GA) + uo;
        u32x4 ga[2][4][2];
#pragma unroll
        for (int ai = 0; ai < 2; ++ai)
#pragma unroll
            for (int m = 0; m < 4; ++m)
#pragma unroll
                for (int bj = 0; bj < 2; ++bj) ga[ai][m][bj] = *(const u32x4*)(GA + (ai * 128 + m * 16) * DM + bj * 128 + lo);
#pragma unroll
        for (int ai = 0; ai < 2; ++ai)
#pragma unroll
            for (int m = 0; m < 4; ++m)
#pragma unroll
                for (int bj = 0; bj < 2; ++bj)
#pragma unroll
                    for (int q = 0; q < 4; ++q) { acc[ai][bj][m][q >> 1][(q & 1) * 2] *= bf_lo(ga[ai][m][bj][q]); acc[ai][bj][m][q >> 1][(q & 1) * 2 + 1] *= bf_hi(ga[ai][m][bj][q]); }
        asm volatile("" ::: "memory");
    }
    __device__ __forceinline__ void operator()(const AccT& acc, const pg8::Unit& u, int wr, int wc, int fr, int fq) const {
        unsigned char* ws = get_args()->ws; const size_t uo = (size_t)(u.pm * 256 + wr * 64) * DM + u.pn * 256; const unsigned lo = (unsigned)fr * DM + 32 * wc + 8 * fq;
        const bf16_t* GS = (const bf16_t*)(ws + WS_GS) + uo; bf16_t* MRG = (bf16_t*)(ws + WS_MRG) + uo;
#pragma unroll
        for (int ai = 0; ai < 2; ++ai) {
            u32x4 gs[4][2];
#pragma unroll
            for (int m = 0; m < 4; ++m)
#pragma unroll
                for (int bj = 0; bj < 2; ++bj) gs[m][bj] = *(const u32x4*)(GS + (ai * 128 + m * 16) * DM + bj * 128 + lo);
#pragma unroll
            for (int m = 0; m < 4; ++m)
#pragma unroll
                for (int bj = 0; bj < 2; ++bj) { const u32x4 s = gs[m][bj]; f32x4 v0 = acc[ai][bj][m][0], v1 = acc[ai][bj][m][1];
                    v0[0] *= fmaxf(bf_lo(s[0]), 1e-30f); v0[1] *= fmaxf(bf_hi(s[0]), 1e-30f); v0[2] *= fmaxf(bf_lo(s[1]), 1e-30f); v0[3] *= fmaxf(bf_hi(s[1]), 1e-30f);
                    v1[0] *= fmaxf(bf_lo(s[2]), 1e-30f); v1[1] *= fmaxf(bf_hi(s[2]), 1e-30f); v1[2] *= fmaxf(bf_lo(s[3]), 1e-30f); v1[3] *= fmaxf(bf_hi(s[3]), 1e-30f);
                    *(u32x4*)(MRG + (ai * 128 + m * 16) * DM + bj * 128 + lo) = pack8(v0, v1); } }
    }
};

struct EpiResid {
    static constexpr bool MID = false; static constexpr int NVM = 32;
    int first, last;
    __device__ __forceinline__ void operator()(const AccT& acc, const pg8::Unit& u, int wr, int wc, int fr, int fq) const {
        unsigned char* ws = get_args()->ws; const size_t uo = (size_t)(u.pm * 256 + wr * 64) * DM + u.pn * 256; const unsigned lo = (unsigned)fr * DM + 32 * wc + 8 * fq;
        float* X = (float*)(ws + WS_X) + uo; bf16_t* XB = (bf16_t*)(ws + WS_XB) + uo; float* ssq = (float*)(ws + WS_SSQ); LAS f32x2* xs = (LAS f32x2*)(lds_base() + XS_OFF);
        const float* base = get_args()->x + uo;
        const int rl0 = wr * 64 + fr;
#pragma unroll
        for (int ai = 0; ai < 2; ++ai) {
            f32x4 bs[4][2][2];
            if (first) {
#pragma unroll
                for (int m = 0; m < 4; ++m)
#pragma unroll
                    for (int bj = 0; bj < 2; ++bj) { const int ro = (ai * 128 + m * 16) * DM + bj * 128; bs[m][bj][0] = *(const f32x4*)(base + ro + lo); bs[m][bj][1] = *(const f32x4*)(base + ro + 4 + lo); }
            } else {
                u32x4 bb[4][2];
#pragma unroll
                for (int m = 0; m < 4; ++m)
#pragma unroll
                    for (int bj = 0; bj < 2; ++bj) bb[m][bj] = *(const u32x4*)(XB + (ai * 128 + m * 16) * DM + bj * 128 + lo);
#pragma unroll
                for (int m = 0; m < 4; ++m)
#pragma unroll
                    for (int bj = 0; bj < 2; ++bj) { const u32x4 b = bb[m][bj];
                        bs[m][bj][0] = (f32x4){bf_lo(b[0]), bf_hi(b[0]), bf_lo(b[1]), bf_hi(b[1])}; bs[m][bj][1] = (f32x4){bf_lo(b[2]), bf_hi(b[2]), bf_lo(b[3]), bf_hi(b[3])}; }
            }
#pragma unroll
            for (int m = 0; m < 4; ++m) { float s2 = 0.f;
#pragma unroll
                for (int bj = 0; bj < 2; ++bj) { const int ro = (ai * 128 + m * 16) * DM + bj * 128;
                    const f32x4 v0 = bs[m][bj][0] + acc[ai][bj][m][0], v1 = bs[m][bj][1] + acc[ai][bj][m][1];
                    if (last) { *(f32x4*)(X + ro + lo) = v0; *(f32x4*)(X + ro + 4 + lo) = v1; }
                    else *(u32x4*)(XB + ro + lo) = pack8(v0, v1);
                    s2 += ((v0[0] * v0[0] + v0[1] * v0[1]) + (v0[2] * v0[2] + v0[3] * v0[3])) + ((v1[0] * v1[0] + v1[1] * v1[1]) + (v1[2] * v1[2] + v1[3] * v1[3])); }
                s2 = sum_x16_x32(s2);
                if (fq == 0) xs[(rl0 + ai * 128 + m * 16) * 4 + wc] = (f32x2){s2, 0.f}; } }
        EPI_BAR();
        const int t = 64 * (4 * wr + wc) + lane_id();
        if (t < 256) { const f32x2 a = xs[t * 4 + 0], b = xs[t * 4 + 1], c = xs[t * 4 + 2], d = xs[t * 4 + 3]; ssq[(size_t)(u.pm * 256 + t) * 8 + u.pn] = (a.x + b.x) + (c.x + d.x); }
        EPI_BAR();
    }
};

struct EpiSwiglu {
    static constexpr bool MID = false; static constexpr int NVM = REP_P6_SKIPEPI ? 0 : 8;
    int pm0, skip;
    __device__ __forceinline__ void operator()(const AccT& acc, const pg8::Unit& u, int wr, int wc, int fr, int fq) const {
        if (skip) { if (acc[0][0][0][0][0] == 12345.678f) *(volatile float*)(get_args()->ws + WS_OH) = 1.f; return; }
        unsigned char* ws = get_args()->ws; bf16_t* HID = (bf16_t*)(ws + WS_HID) + (size_t)(u.pm * 256 + wr * 64) * FFH + u.pn * 128; const unsigned lo = (unsigned)fr * FFH + 32 * wc + 8 * fq;
        const int rl0 = wr * 64 + fr;
        float rs[8]; load_rstd(rs, (const float*)(ws + WS_SSQ), u.pm, pm0, rl0);
#pragma unroll
        for (int ai = 0; ai < 2; ++ai)
#pragma unroll
            for (int m = 0; m < 4; ++m) { const float r = rs[ai * 4 + m], rn = r * (-1.4426950408889634f), r2 = r * r;
                f32x2 a2[4], b2[4], den[4], rc[4], ab[4];
#pragma unroll
                for (int i = 0; i < 4; ++i) { a2[i] = (f32x2){acc[ai][0][m][i >> 1][(i & 1) * 2], acc[ai][0][m][i >> 1][(i & 1) * 2 + 1]}; b2[i] = (f32x2){acc[ai][1][m][i >> 1][(i & 1) * 2], acc[ai][1][m][i >> 1][(i & 1) * 2 + 1]}; }
#pragma unroll
                for (int i = 0; i < 4; ++i) { const f32x2 t = a2[i] * rn; den[i].x = __builtin_amdgcn_exp2f(t.x); den[i].y = __builtin_amdgcn_exp2f(t.y); }
                __builtin_amdgcn_sched_barrier(0);
#pragma unroll
                for (int i = 0; i < 4; ++i) ab[i] = (a2[i] * b2[i]) * r2;
                __builtin_amdgcn_sched_barrier(0);
#pragma unroll
                for (int i = 0; i < 4; ++i) { den[i] = den[i] + 1.0f; rc[i].x = __builtin_amdgcn_rcpf(den[i].x); rc[i].y = __builtin_amdgcn_rcpf(den[i].y); }
                __builtin_amdgcn_sched_barrier(0);
                f32x4 o[2];
#pragma unroll
                for (int i = 0; i < 4; ++i) { const f32x2 res = ab[i] * rc[i]; o[i >> 1][(i & 1) * 2] = res.x; o[i >> 1][(i & 1) * 2 + 1] = res.y; }
                *(u32x4*)(HID + (ai * 128 + m * 16) * FFH + lo) = pack8(o[0], o[1]); }
    }
};

namespace att {
using bf16 = __hip_bfloat16;
constexpr int D = 128;
constexpr float THR = 8.f;
constexpr bool WSKIP = false;
constexpr float SCALE = 0.08838834764831845f;
constexpr float QSC = 1.4426950408889634f * SCALE;
constexpr float THR2 = THR * 1.4426950408889634f;
constexpr int NW = 8, QBLK = 32, KVBLK = 64, QB = NW * QBLK;
constexpr int SHM_V = KVBLK * D * 2, SHM_K = KVBLK * D * 2;
constexpr int LDS_ATT = 2 * SHM_V + 2 * SHM_K + NW * 64 * 4;
template <class A, class Bt> struct same_t { static constexpr bool v = false; };
template <class A> struct same_t<A, A> { static constexpr bool v = true; };
#define KSWZ(row, colB) ((row) * 256 + ((colB) ^ (((row) & 7) << 4)))
#define SBAR() __builtin_amdgcn_sched_barrier(0)
__device__ __forceinline__ int v_st(int k, int c) { const int kk = (k & ~0xC) | ((k & 4) << 1) | ((k & 8) >> 1); return ((kk >> 3) * 4 + (c >> 5)) * 512 + ((kk & 7) * 32 + (c & 31)) * 2; }
__device__ __forceinline__ int v_rd_base(int lane) { return ((lane & 3) << 3) | (((lane >> 2) & 3) << 6) | (((lane >> 4) & 1) << 5) | (((lane >> 5) & 1) << 11); }
constexpr int v_rd_off(int d0, int ks, int half) { return d0 * 512 + ks * 4096 + half * 2048; }
__device__ __forceinline__ int crow(int r, int hi) { return (r & 3) + 8 * (r >> 2) + 4 * hi; }
__device__ __forceinline__ unsigned cvtpk(float lo, float hi) { return cvt_pk_bf16(lo, hi); }
__device__ __forceinline__ bf16x8 pack8(f32x4 a, f32x4 b) { u32x4 w = {cvtpk(a[0], a[1]), cvtpk(a[2], a[3]), cvtpk(b[0], b[1]), cvtpk(b[2], b[3])}; return *reinterpret_cast<bf16x8*>(&w); }
template <class T> __device__ __forceinline__ bf16x8 load8(const T* p) {
    if constexpr (same_t<T, float>::v) { return pack8(*(const f32x4*)p, *(const f32x4*)(p + 4)); }
    else { return *reinterpret_cast<const bf16x8*>(p); }
}
__device__ __forceinline__ void mask_tile(f32x16& p0, f32x16& p1, int dq, unsigned W) {
    const float NEG = -__builtin_inff();
#pragma unroll
    for (int r = 0; r < 16; ++r) {
        const int c = (r & 3) + 8 * (r >> 2);
        if ((unsigned)(dq - c) >= W) p0[r] = NEG;
        if ((unsigned)(dq - c - 32) >= W) p1[r] = NEG;
    }
}
__device__ __forceinline__ void partialSM(f32x16& p0, f32x16& p1, float& m_reg, f32x16& cneg, bool first, float& alpha) {
    float pm_[4] = {p0[0], p0[1], p0[2], p0[3]};
    for (int r = 4; r < 16; ++r) pm_[r & 3] = fmaxf(pm_[r & 3], p0[r]); for (int r = 0; r < 16; ++r) pm_[r & 3] = fmaxf(pm_[r & 3], p1[r]);
    float pmax = fmaxf(fmaxf(pm_[0], pm_[1]), fmaxf(pm_[2], pm_[3]));
    if (__builtin_expect(!first && __all(pmax <= THR2), 1)) { alpha = 1.f; }
    else { { auto rr = __builtin_amdgcn_permlane32_swap(__float_as_uint(pmax), __float_as_uint(pmax), false, false);
             pmax = fmaxf(__uint_as_float(rr[0]), __uint_as_float(rr[1])); }
        const float dl = first ? fmaxf(pmax, -1.0e4f) : fmaxf(pmax, 0.f);
        alpha = first ? 1.f : __builtin_amdgcn_exp2f(-dl); m_reg += dl;
        for (int r = 0; r < 16; ++r) { p0[r] -= dl; p1[r] -= dl; }
        const float nm = -m_reg; for (int r = 0; r < 16; ++r) cneg[r] = nm; }
    for (int r = 0; r < 16; ++r) p0[r] = __builtin_amdgcn_exp2f(p0[r]);
}
__device__ __forceinline__ void finishSM(f32x16& p0, f32x16& p1, float alpha, float& l_reg, bf16x8& pa0, bf16x8& pa1, bf16x8& pa2, bf16x8& pa3) {
    for (int r = 0; r < 16; ++r) p1[r] = __builtin_amdgcn_exp2f(p1[r]);
    float ps_[4] = {p0[0], p0[1], p0[2], p0[3]}; for (int r = 4; r < 16; ++r) ps_[r & 3] += p0[r]; for (int r = 0; r < 16; ++r) ps_[r & 3] += p1[r];
    const float ps = (ps_[0] + ps_[1]) + (ps_[2] + ps_[3]);
    l_reg = l_reg * alpha + ps;
#define PK4(P, B_, OUT) do { u32x4 w = {cvtpk(P[B_+0], P[B_+1]), cvtpk(P[B_+2], P[B_+3]), cvtpk(P[B_+4], P[B_+5]), cvtpk(P[B_+6], P[B_+7])}; OUT = *reinterpret_cast<bf16x8*>(&w); } while (0)
    PK4(p0, 0, pa0); PK4(p0, 8, pa1); PK4(p1, 0, pa2); PK4(p1, 8, pa3);
#undef PK4
}
template <int KB, bool SK>
__device__ __forceinline__ void qkt(f32x16& p0, f32x16& p1, const char* K_lds, int r32, int hi, const bf16x8* qr, bool act) {
    if (SK && !act) { const float NEG = -__builtin_inff();
#pragma unroll
        for (int r = 0; r < 16; ++r) { p0[r] = NEG; p1[r] = NEG; } return; }
    p0 = f32x16{}; p1 = f32x16{};
    const char* kb[4];
#pragma unroll
    for (int dd = 0; dd < 4; ++dd) kb[dd] = K_lds + KB * SHM_K + KSWZ(r32, (dd * 16 + hi * 8) * 2);
#pragma unroll
    for (int d0 = 0; d0 < 8; ++d0) { const char* a = kb[d0 & 3] + (d0 >> 2) * 128;
        bf16x8 b0 = *reinterpret_cast<const bf16x8*>(a);
        bf16x8 b1 = *reinterpret_cast<const bf16x8*>(a + 32 * 256);
        p0 = __builtin_amdgcn_mfma_f32_32x32x16_bf16(b0, qr[d0], p0, 0, 0, 0);
        p1 = __builtin_amdgcn_mfma_f32_32x32x16_bf16(b1, qr[d0], p1, 0, 0, 0); }
}
template <int VB, bool SK>
__device__ __forceinline__ void pv_tile(f32x16* o, int vb0, bf16x8 pa0, bf16x8 pa1, bf16x8 pa2, bf16x8 pa3, bool act) {
    if (SK && !act) return;
#define TRRD(dst, off) asm volatile("ds_read_b64_tr_b16 %0, %1 offset:%2" : "=&v"(dst) : "v"(vb0), "i"(off) : "memory")
#define PV_D0(d0) do { s16x4 l0, l1, l2, l3, h0, h1, h2, h3; constexpr int b_ = VB * SHM_V + v_rd_off(d0, 0, 0); \
        TRRD(l0, b_); TRRD(h0, b_ + 256); TRRD(l1, b_ + 4096); TRRD(h1, b_ + 4352); TRRD(l2, b_ + 8192); TRRD(h2, b_ + 8448); TRRD(l3, b_ + 12288); TRRD(h3, b_ + 12544); \
        asm volatile("s_waitcnt lgkmcnt(0)" ::: "memory"); SBAR();   \
        o[d0] = __builtin_amdgcn_mfma_f32_32x32x16_bf16(pa0, (bf16x8){l0[0], l0[1], l0[2], l0[3], h0[0], h0[1], h0[2], h0[3]}, o[d0], 0, 0, 0);   \
        o[d0] = __builtin_amdgcn_mfma_f32_32x32x16_bf16(pa1, (bf16x8){l1[0], l1[1], l1[2], l1[3], h1[0], h1[1], h1[2], h1[3]}, o[d0], 0, 0, 0);   \
        o[d0] = __builtin_amdgcn_mfma_f32_32x32x16_bf16(pa2, (bf16x8){l2[0], l2[1], l2[2], l2[3], h2[0], h2[1], h2[2], h2[3]}, o[d0], 0, 0, 0);   \
        o[d0] = __builtin_amdgcn_mfma_f32_32x32x16_bf16(pa3, (bf16x8){l3[0], l3[1], l3[2], l3[3], h3[0], h3[1], h3[2], h3[3]}, o[d0], 0, 0, 0); } while (0)
    PV_D0(0); PV_D0(1); PV_D0(2); PV_D0(3);
#undef PV_D0
#undef TRRD
}
#undef KSWZ
#undef SBAR
}

namespace datt {
using namespace att;
constexpr int STAGE = 65536, K_OFF = 0, V_OFF = 32768;
#define DSBAR() __builtin_amdgcn_sched_barrier(0)
#define DKSWZ(row, colB) ((row) * 256 + ((colB) ^ (((row) & 7) << 4)))
__device__ __forceinline__ void qkt_rt(f32x16& p0, f32x16& p1, int Kt  , int r32, int hi, const bf16x8* qr, const f32x16& cneg  ) {
    int kb[4];
#pragma unroll
    for (int dd = 0; dd < 4; ++dd) kb[dd] = Kt + DKSWZ(r32, (dd * 16 + hi * 8) * 2);
#define KRD(dst, a_, off) asm volatile("ds_read_b128 %0, %1 offset:%2" : "=&v"(dst) : "v"(a_), "i"(off) : "memory")
#define KWAIT(n) asm volatile("s_waitcnt lgkmcnt(" #n ")" ::: "memory")
    bf16x8 a0, a1, b0, b1;
    KRD(a0, kb[0], 0); KRD(a1, kb[0], 8192); KRD(b0, kb[1], 0); KRD(b1, kb[1], 8192);
#define QSTEP(d0, X0, X1, nd, NXT) do { if (NXT) KWAIT(2); else KWAIT(0); DSBAR(); \
        p0 = __builtin_amdgcn_mfma_f32_32x32x16_bf16(X0, qr[d0], p0, 0, 0, 0); p1 = __builtin_amdgcn_mfma_f32_32x32x16_bf16(X1, qr[d0], p1, 0, 0, 0); DSBAR(); \
        if (NXT) { KRD(X0, kb[(nd) & 3], ((nd) >> 2) * 128); KRD(X1, kb[(nd) & 3], ((nd) >> 2) * 128 + 8192); } } while (0)
    KWAIT(2); DSBAR(); p0 = __builtin_amdgcn_mfma_f32_32x32x16_bf16(a0, qr[0], cneg, 0, 0, 0); p1 = __builtin_amdgcn_mfma_f32_32x32x16_bf16(a1, qr[0], cneg, 0, 0, 0); DSBAR(); KRD(a0, kb[2 & 3], (2 >> 2) * 128); KRD(a1, kb[2 & 3], (2 >> 2) * 128 + 8192);
    QSTEP(1, b0, b1, 3, 1); QSTEP(2, a0, a1, 4, 1); QSTEP(3, b0, b1, 5, 1);
    QSTEP(4, a0, a1, 6, 1); QSTEP(5, b0, b1, 7, 1);
    KWAIT(2); DSBAR(); p0 = __builtin_amdgcn_mfma_f32_32x32x16_bf16(a0, qr[6], p0, 0, 0, 0); p1 = __builtin_amdgcn_mfma_f32_32x32x16_bf16(a1, qr[6], p1, 0, 0, 0);
    KWAIT(0); DSBAR(); p0 = __builtin_amdgcn_mfma_f32_32x32x16_bf16(b0, qr[7], p0, 0, 0, 0); p1 = __builtin_amdgcn_mfma_f32_32x32x16_bf16(b1, qr[7], p1, 0, 0, 0);
#undef QSTEP
#undef KWAIT
#undef KRD
}
template <int MODE>
__device__ __forceinline__ void dattn_unit(const bf16_t* QH, const bf16_t* KH, const bf16_t* VH, bf16_t* A2, int bh, int qb, float lamf  , const float* gain  , int lay  , char* lds, float* scr, const int tid, const int rot  ) {
    int tid_ = tid; asm volatile("" : "+v"(tid_));
    const int wid = __builtin_amdgcn_readfirstlane(tid_ >> 6), lane = tid_ & 63, r32 = lane & 31, hi = lane >> 5, c = wid >> 2, p = wid & 3;
    const int row0 = qb * 128, qlo = row0 + 32 * p, qm = qlo + r32 - 4 * hi, NT = 2 * qb + 2;
    const bf16_t* Qc = QH + ((size_t)(bh * 2 + c) * SEQ + qlo) * HDIM; const char* Kc = (const char*)(KH + (size_t)(bh * 2 + c) * SEQ * HDIM);
    const char* V0 = (const char*)(VH + (size_t)(bh * 2) * SEQ * HDIM);
    float* li_l = scr + wid * 64, * al_l = li_l + 32;
    const char* K1h = (const char*)(KH + (size_t)(bh * 2) * SEQ * HDIM); const char* K2h = K1h + (size_t)SEQ * HDIM * 2; const char* V1 = V0 + (size_t)SEQ * HDIM * 2;
#define DMA16(g, l_) __builtin_amdgcn_global_load_lds((const unsigned*)(g), (LAS unsigned*)(l_), 16, 0, 0)
    unsigned koff0_, voff0_;
    { const int row_ = 8 * wid + (lane >> 4), ch_ = (lane & 15) ^ (row_ & 7); koff0_ = (unsigned)(row_ * 256 + ch_ * 16);
      const int kk_ = 8 * wid + ((lane & 31) >> 2), k_ = (kk_ & ~0xC) | ((kk_ & 4) << 1) | ((kk_ & 8) >> 1), cc_ = 32 * (lane >> 5) + 8 * (lane & 3); voff0_ = (unsigned)(k_ * 256 + cc_ * 2); }
#define STAGE_TILE(t_, st_) do { const size_t kb_ = (size_t)(t_) * 64 * 256; LAS unsigned char* sb_ = lds_base() + (st_) * STAGE; \
        const unsigned koff1_ = (koff0_ ^ 64u) + 1024u, voff1_ = voff0_ + 128u; \
        DMA16(K1h + kb_ + koff0_, sb_ + K_OFF + (8 * wid) * 256); DMA16(K2h + kb_ + koff0_, sb_ + K_OFF + 16384 + (8 * wid) * 256); \
        DMA16(V0 + kb_ + voff0_, sb_ + V_OFF + (2 * wid) * 1024); DMA16(V1 + kb_ + voff0_, sb_ + V_OFF + 16384 + (2 * wid) * 1024); \
        DMA16(K1h + kb_ + koff1_, sb_ + K_OFF + (8 * wid + 4) * 256); DMA16(K2h + kb_ + koff1_, sb_ + K_OFF + 16384 + (8 * wid + 4) * 256); \
        DMA16(V0 + kb_ + voff1_, sb_ + V_OFF + (2 * wid + 1) * 1024); DMA16(V1 + kb_ + voff1_, sb_ + V_OFF + 16384 + (2 * wid + 1) * 1024); } while (0)
    bf16x8 qr[8];
#pragma unroll
    for (int d0 = 0; d0 < 8; ++d0) qr[d0] = *reinterpret_cast<const bf16x8*>(Qc + (unsigned)(r32 * HDIM + d0 * 16 + hi * 8));
    if (MODE != 4) STAGE_TILE(rot, 0);
    float m_reg = 0.f, l_reg = 0.f; f32x16 o[8] = {};
    f32x16 cneg = {};
    f32x16 p0, p1; float alpha; bf16x8 pa0, pa1, pa2, pa3; bool fresh = true;
    const int vrb = v_rd_base(lane);
    for (int i = 0; i < NT; ++i) { int t = i + rot; if (t >= NT) t -= NT; int tn = t + 1; if (tn >= NT) tn = 0;
        asm volatile("s_waitcnt vmcnt(0)" ::: "memory"); __builtin_amdgcn_s_barrier(); asm volatile("" ::: "memory");
        const int kbase = t * 64; const bool act = kbase <= qlo + 31;
        if (MODE != 4 && i + 1 < NT) STAGE_TILE(tn, (i + 1) & 1);
        if (act) { const int Kt = (i & 1) * STAGE + K_OFF + c * 16384;
            DSBAR(); if (MODE != 3) qkt_rt(p0, p1, Kt, r32, hi, qr, cneg); else { p0 = f32x16{}; p1 = f32x16{}; } DSBAR(); }
        if (act) {
            if (kbase + 63 > qlo) mask_tile(p0, p1, qm - kbase, 0x7fffffffu);
            if (MODE != 1) { partialSM(p0, p1, m_reg, cneg, fresh, alpha); fresh = false;
            finishSM(p0, p1, alpha, l_reg, pa0, pa1, pa2, pa3); } else { alpha = 1.f; l_reg = 1.f; pa0 = att::pack8((f32x4){p0[0],p0[1],p0[2],p0[3]}, (f32x4){p0[4],p0[5],p0[6],p0[7]}); pa1 = att::pack8((f32x4){p0[8],p0[9],p0[10],p0[11]}, (f32x4){p0[12],p0[13],p0[14],p0[15]}); pa2 = att::pack8((f32x4){p1[0],p1[1],p1[2],p1[3]}, (f32x4){p1[4],p1[5],p1[6],p1[7]}); pa3 = att::pack8((f32x4){p1[8],p1[9],p1[10],p1[11]}, (f32x4){p1[12],p1[13],p1[14],p1[15]}); } DSBAR();
            if (__any(alpha < 1.f)) { if (hi == 0) al_l[r32] = alpha; asm volatile("s_waitcnt lgkmcnt(0)" ::: "memory");
#pragma unroll
                for (int d_ = 0; d_ < 8; ++d_)
#pragma unroll
                    for (int r = 0; r < 16; ++r) o[d_][r] *= al_l[crow(r, hi)]; }
            const int vb = (i & 1) * STAGE + V_OFF + vrb;
            if (MODE != 2) { pv_tile<0, false>(o, vb, pa0, pa1, pa2, pa3, true); pv_tile<0, false>(o + 4, vb + 16384, pa0, pa1, pa2, pa3, true); } else { o[0][0] += __uint_as_float((unsigned)pa0[0] + (unsigned)pa1[0] + (unsigned)pa2[0] + (unsigned)pa3[0]); }
        }
    }
    { auto rr = __builtin_amdgcn_permlane32_swap(__float_as_uint(l_reg), __float_as_uint(l_reg), false, false); l_reg = __uint_as_float(rr[0]) + __uint_as_float(rr[1]); }
    if (hi == 0) li_l[r32] = (c ? lamf : 1.0f) * __builtin_amdgcn_rcpf(l_reg);
    asm volatile("s_waitcnt lgkmcnt(0)" ::: "memory");
    float rli[16];
#pragma unroll
    for (int r = 0; r < 16; ++r) rli[r] = li_l[crow(r, hi)];
    __builtin_amdgcn_s_barrier(); asm volatile("" ::: "memory");
    LAS float* ex = (LAS float*)(lds_base() + p * 32768);
    if (c == 1) {
#pragma unroll
        for (int d0 = 0; d0 < 8; ++d0)
#pragma unroll
            for (int r = 0; r < 16; ++r) ex[crow(r, hi) * 256 + d0 * 32 + r32] = o[d0][r] * rli[r];
    }
    asm volatile("s_waitcnt lgkmcnt(0)" ::: "memory"); __builtin_amdgcn_s_barrier(); asm volatile("" ::: "memory");
    if (c == 0) {
#pragma unroll
        for (int d0 = 0; d0 < 8; ++d0)
#pragma unroll
            for (int r = 0; r < 16; ++r) { const int a = crow(r, hi) * 256 + d0 * 32 + r32; ex[a] = o[d0][r] * rli[r] - ex[a]; }
    }
    asm volatile("s_waitcnt lgkmcnt(0)" ::: "memory"); __builtin_amdgcn_s_barrier(); asm volatile("" ::: "memory");
    {
        const int b = bh >> 3, h = bh & 7;
        bf16_t* outp = A2 + ((size_t)(b * SEQ + row0 + 16 * wid)) * KBR + h * 256;
        int lay_ = lay; asm volatile("" : "+s"(lay_));
        const float gsc_ = 1.0f - (0.8f - 0.6f * expf(-0.3f * (float)lay_));
        const f32x4 gain4 = *(const f32x4*)(gain + 4 * lane) * gsc_;
#pragma unroll 4
        for (int i = 0; i < 16; ++i) { const int R = 16 * wid + i;
            const f32x4 x = *(const LAS f32x4*)(lds_base() + (R >> 5) * 32768 + (R & 31) * 1024 + lane * 16);
            const float ss = wave_sum((x[0] * x[0] + x[1] * x[1]) + (x[2] * x[2] + x[3] * x[3]), lane);
            const float rs = __builtin_amdgcn_rsqf(ss * (1.0f / 256.0f) + EPS); const f32x4 y = x * rs * gain4;
            u32x2 w; w.x = cvt_pk_bf16(y[0], y[1]); w.y = cvt_pk_bf16(y[2], y[3]); *(u32x2*)(outp + (size_t)i * KBR + (unsigned)(4 * lane)) = w; }
    }
    asm volatile("s_waitcnt lgkmcnt(0)" ::: "memory"); __builtin_amdgcn_s_barrier(); asm volatile("" ::: "memory");
#undef STAGE_TILE
#undef DMA16
}

#undef DSBAR
#undef DKSWZ
}

#define XB_TMO      128
#define XB_XCNT(j)  (256  + 64 * (j))
#define XB_XSUB(j)  (1280 + 64 * (j))
#define XB_XGEN(j)  (2304 + 64 * (j))
#define XB_TOP      3328
#define XB_TOPGEN   3392
#define XCD_BAR_WORDS 3456
#define XB_SPIN_CAP (1u << 18)
__device__ __forceinline__ unsigned xb_ld(unsigned* p)              { return __hip_atomic_load(p, __ATOMIC_RELAXED, __HIP_MEMORY_SCOPE_AGENT); }
__device__ __forceinline__ unsigned xb_add(unsigned* p, unsigned v) { return __hip_atomic_fetch_add(p, v, __ATOMIC_RELAXED, __HIP_MEMORY_SCOPE_AGENT); }
__device__ __forceinline__ unsigned xb_xcc_id() { return (unsigned)__builtin_amdgcn_s_getreg((3 << 11) | 20) & 0xFu; }
#define XB_SPIN(cond, bar) do { unsigned _sp = 0; while (cond) { __builtin_amdgcn_s_sleep(1); \
    if ((++_sp & 255u) == 0u) { if (xb_ld(&(bar)[XB_TMO])) break; if (_sp > XB_SPIN_CAP) { atomicAdd(&(bar)[XB_TMO], 1u); break; } } } } while (0)
struct XcdBarrier { unsigned* bar; unsigned x; volatile LAS unsigned* st; };
__device__ __forceinline__ XcdBarrier xcd_barrier_post(unsigned* bar, volatile LAS unsigned* st, const bool leader) {
    XcdBarrier b; b.bar = bar; b.x = xb_xcc_id(); b.st = st;
    if (leader) (void)xb_add(&bar[XB_XCNT(b.x)], 1u);
    return b;
}
__device__ __forceinline__ void xcd_barrier_complete(unsigned* bar, unsigned x, unsigned& nloc, unsigned& nx) {
    const unsigned G = gridDim.x * gridDim.y * gridDim.z;
    unsigned sum, cnt, mine, sp = 0u;
    for (;;) {
        sum = 0u; cnt = 0u; mine = 0u;
#pragma unroll
        for (unsigned j = 0; j < 16; ++j) { const unsigned c = xb_ld(&bar[XB_XCNT(j)]); sum += c; cnt += (c > 0u) ? 1u : 0u; mine = (j == x) ? c : mine; }
        if (sum == G) break;
        __builtin_amdgcn_s_sleep(1);
        if ((++sp & 255u) == 0u) { if (xb_ld(&bar[XB_TMO])) break; if (sp > XB_SPIN_CAP) { atomicAdd(&bar[XB_TMO], 1u); break; } }
    }
    nloc = mine > 0u ? mine : 1u; nx = cnt > 0u ? cnt : 1u;
}
__device__ __forceinline__ void xcd_barrier(const XcdBarrier& b, const bool leader) {
    asm volatile("s_waitcnt vmcnt(0)" ::: "memory");
    __syncthreads();
    if (leader) {
        unsigned* bar = b.bar;
        __builtin_amdgcn_s_waitcnt(0);
        unsigned nloc = b.st[0], nx = b.st[1];
        if (nloc == 0u) { xcd_barrier_complete(bar, b.x, nloc, nx); b.st[0] = nloc; b.st[1] = nx; }
        const unsigned old = xb_add(&bar[XB_XSUB(b.x)], 1u);
        const unsigned gen = old / nloc;
        if (old + 1u == (gen + 1u) * nloc) {
            __builtin_amdgcn_fence(__ATOMIC_RELEASE, "agent");
            asm volatile("s_waitcnt vmcnt(0)" ::: "memory");
            const unsigned og = xb_add(&bar[XB_TOP], 1u);
            const unsigned tg = og / nx;
            if (og + 1u == (tg + 1u) * nx) xb_add(&bar[XB_TOPGEN], 1u);
            else XB_SPIN(xb_ld(&bar[XB_TOPGEN]) == tg, bar);
            __builtin_amdgcn_fence(__ATOMIC_ACQUIRE, "agent");
            xb_add(&bar[XB_XGEN(b.x)], 1u);
            asm volatile("s_waitcnt vmcnt(0)" ::: "memory");
        } else {
            XB_SPIN(xb_ld(&bar[XB_XGEN(b.x)]) == gen, bar);
            __builtin_amdgcn_fence(__ATOMIC_ACQUIRE, "agent");
            asm volatile("s_waitcnt vmcnt(0)" ::: "memory");
        }
    }
    __syncthreads();
}

struct TrItem { const float* W; const float* gain; bf16_t* WT; int ldw, src0, ldo, n0, kcol0, k0; float osc; };
__device__ __forceinline__ void transpose_load(const TrItem& d, f32x4 (&v)[16], int lane) {
    const int rsub = lane >> 4, c4 = lane & 15;
    const float* wp = d.W + (size_t)(d.k0 + rsub) * d.ldw + d.src0; const unsigned lo = 4u * c4;
#pragma unroll
    for (int i = 0; i < 16; ++i) v[i] = __builtin_nontemporal_load((const f32x4*)(wp + (size_t)(4 * i) * d.ldw + lo));
}
__device__ __forceinline__ void transpose_finish(const TrItem& d, f32x4 (&v)[16], LAS float* scr, int lane) {
    const int rsub = lane >> 4, c4 = lane & 15;
    if (d.gain) {
#pragma unroll
        for (int i = 0; i < 16; ++i) v[i] = v[i] * (d.gain[d.k0 + 4 * i + rsub] * d.osc); }
#pragma unroll
    for (int i = 0; i < 16; ++i) { LAS float* p = scr + (4 * i + rsub) * 65 + 4 * c4; p[0] = v[i][0]; p[1] = v[i][1]; p[2] = v[i][2]; p[3] = v[i][3]; }
    asm volatile("s_waitcnt lgkmcnt(0)" ::: "memory");
    const int c = lane & 7, nl = lane >> 3;
    bf16_t* op = d.WT + (size_t)d.n0 * d.ldo + d.kcol0 + d.k0; const unsigned so = (unsigned)nl * d.ldo + 8u * c;
#pragma unroll
    for (int j = 0; j < 8; ++j) { const LAS float* sp = scr + (8 * c) * 65 + nl + 8 * j;
        u32x4 o; o.x = cvt_pk_bf16(sp[0 * 65], sp[1 * 65]); o.y = cvt_pk_bf16(sp[2 * 65], sp[3 * 65]); o.z = cvt_pk_bf16(sp[4 * 65], sp[5 * 65]); o.w = cvt_pk_bf16(sp[6 * 65], sp[7 * 65]);
        *(u32x4*)(op + (size_t)(8 * j) * d.ldo + so) = o; }
    asm volatile("s_waitcnt lgkmcnt(0)" ::: "memory");
}
__device__ __forceinline__ int src_in(int n) {
    if (n >= 10240) { const int g = (n - 10240) >> 8, w = n & 255; return 10240 + (w >> 7) * 2048 + g * 128 + (w & 127); }
    if (n >= 4096) return n;
    const int r = n >> 11, nn = n & 2047, h = nn >> 8, w = nn & 255, bj = w >> 7, c = (w >> 6) & 1, d = w & 63;
    return r * 2048 + h * 256 + c * 128 + bj * 64 + d;
}
__device__ __forceinline__ int src_ffi(int n) { const int pn = n >> 8, w = n & 255, bj = w >> 7, p = w & 127; return bj * FFH + pn * 128 + p; }

#define PH_ARGS() ArgP ap = get_args(); unsigned char* ws = ap->ws; (void)ws; int bid_ = blockIdx.x, G_ = gridDim.x; asm volatile("" : "+s"(bid_), "+s"(G_)); (void)bid_; (void)G_
__global__ void __launch_bounds__(512, 2) mk_fwd(Args args_unused) {
    LAS unsigned char* lds = lds_base();
    volatile LAS unsigned* MISC = (volatile LAS unsigned*)(lds + MISC_OFF);
    const int wv = __builtin_amdgcn_readfirstlane((int)threadIdx.x >> 6);
    for (int u = TID_OF(wv); u < (LDS_BYTES - MISC_OFF) / 4; u += 512) MISC[u] = 0u;
    __syncthreads();
    XcdBarrier bar; bar.bar = nullptr; bar.x = 0; bar.st = nullptr;
    if (!MK_MULTI) { ArgP ap0 = get_args(); bar = xcd_barrier_post((unsigned*)(ap0->ws + WS_CTL) + CW_BAR, MISC + 8, TID_OF(wv) == 0); }
    int lo, hi; { ArgP ap0 = get_args(); lo = ap0->ph_lo; hi = ap0->ph_hi; }
#define IN(k) (lo <= (k) && (k) < hi && (DBG_CUT == 0 || (k) < DBG_CUT || (k) == 29))
#define GRID_BAR(k) do { if (IN(k) && IN((k) + 1)) xcd_barrier(bar, TID_OF(wv) == 0); } while (0)

    for (int rep = 0; rep < REP_P0; ++rep)
    if (EN_P0 && IN(0)) {
        PH_ARGS();
        const int tid = TID_OF(wv), lane = tid & 63, wid = wv, G = gridDim.x, bid = blockIdx.x, gw = bid * 8 + wid, NGW = G * 8;
        LAS float* scr = (LAS float*)(lds + wid * 16640);
        constexpr int NB_IN = INCOLS / 64, NB_D = DM / 64, NB_FI = 2 * FFH / 64, KB_D = DM / 64, KB_FO = FFH / 64;
        constexpr int I_IN = KB_D * NB_IN, I_BR = KB_D * NB_D, I_OUT = I_BR, I_FI = KB_D * NB_FI, I_FO = KB_FO * NB_D;
        constexpr int I_LAYER = I_IN + 2 * I_BR + I_OUT + I_FI + I_FO;
        auto decode = [&](int it) -> TrItem { const int l = it / I_LAYER; int r = it - l * I_LAYER; TrItem d;
            if (r < I_IN) { const int kb = r / NB_IN, nb = r - kb * NB_IN, n0 = nb * 64;
                d = TrItem{ap->w_in + (size_t)l * DM * INCOLS, ap->norm_attn + l * DM, (bf16_t*)(ws + WS_WIN + l * SZ_WIN), INCOLS, src_in(n0), DM, n0, 0, kb * 64, n0 < DM ? att::QSC : 1.0f}; return d; }
            r -= I_IN;
            if (r < 2 * I_BR) { const int br = r / I_BR, rr = r - br * I_BR, kb = rr / NB_D, nb = rr - kb * NB_D, n0 = nb * 64;
                d = TrItem{ap->w_branch + ((size_t)l * 2 + br) * DM * DM, nullptr, (bf16_t*)(ws + WS_WBR + l * SZ_WBR), DM, n0, KBR, n0, br * DM, kb * 64, 1.0f}; return d; }
            r -= 2 * I_BR;
            if (r < I_OUT) { const int kb = r / NB_D, nb = r - kb * NB_D, n0 = nb * 64;
                d = TrItem{ap->w_out + (size_t)l * DM * DM, nullptr, (bf16_t*)(ws + WS_WOUT + l * SZ_WOUT), DM, n0, DM, n0, 0, kb * 64, 1.0f}; return d; }
            r -= I_OUT;
            if (r < I_FI) { const int kb = r / NB_FI, nb = r - kb * NB_FI, n0 = nb * 64;
                d = TrItem{ap->w_ffn_in + (size_t)l * DM * 2 * FFH, ap->norm_ffn + l * DM, (bf16_t*)(ws + WS_WFI + l * SZ_WFI), 2 * FFH, src_ffi(n0), DM, n0, 0, kb * 64, 1.0f}; return d; }
            r -= I_FI;
            { const int kb = r / NB_D, nb = r - kb * NB_D, n0 = nb * 64;
                d = TrItem{ap->w_ffn_out + (size_t)l * FFH * DM, nullptr, (bf16_t*)(ws + WS_WFO + l * SZ_WFO), DM, n0, FFH, n0, 0, kb * 64, 1.0f}; return d; } };
        for (int it = gw; it < DEPTH * I_LAYER; it += 2 * NGW) {
            const bool two = it + NGW < DEPTH * I_LAYER;
            const TrItem d0 = decode(it), d1 = decode(two ? it + NGW : it);
            f32x4 v0[16], v1[16];
            transpose_load(d0, v0, lane); if (two) transpose_load(d1, v1, lane);
            transpose_finish(d0, v0, scr, lane); if (two) transpose_finish(d1, v1, scr, lane);
        }
        { bf16_t* XB = (bf16_t*)(ws + WS_XB); float* SSQ = (float*)(ws + WS_SSQ); const float* x = ap->x;
        for (int m = gw; m < MTOK; m += NGW) {
            const f32x4* xr = (const f32x4*)(x + (size_t)m * DM) + lane; float s = 0.f;
#pragma unroll
            for (int j = 0; j < 8; ++j) { const f32x4 v = xr[64 * j]; s += (v[0] * v[0] + v[1] * v[1]) + (v[2] * v[2] + v[3] * v[3]);
                u32x2 w; w.x = cvt_pk_bf16(v[0], v[1]); w.y = cvt_pk_bf16(v[2], v[3]); *((u32x2*)(XB + (size_t)m * DM) + lane + 64 * j) = w; }
            s = wave_sum(s, lane);
            if (lane < 8) SSQ[(size_t)m * 8 + lane] = lane == 0 ? s : 0.f;
        } }
        { _Float16* COS = (_Float16*)(ws + WS_COS); _Float16* SIN = (_Float16*)(ws + WS_SIN); const int* pos = ap->pos;
        for (int i = bid * 512 + tid; i < MTOK * 64; i += G * 512) { const int m = i >> 6, d = i & 63;
            const float inv = powf(10000.0f, -(float)(2 * d) * (1.0f / 128.0f)); const float ang = (float)pos[m] * inv;
            const double t = (double)ang * 0.15915494309189535; const float fr = (float)(t - rint(t));
            COS[i] = (_Float16)__builtin_amdgcn_cosf(fr); SIN[i] = (_Float16)__builtin_amdgcn_sinf(fr); } }
        { bf16_t* WST = (bf16_t*)(ws + WS_WST); const float* wsp = ap->w_spatial;
        for (int i = bid * 512 + tid; i < DEPTH * 8 * 128 * 128; i += G * 512) { const int jj = i & 127, ii = (i >> 7) & 127; const float v = jj <= ii ? wsp[i] : 0.f; WST[i] = (bf16_t)(cvt_pk_bf16(v, 0.f) & 0xffffu); } }
    }
    GRID_BAR(0);

    for (int l = 0; l < DEPTH; ++l) {
        const int pb = 1 + 7 * l;
        for (int rep = 0; rep < REP_P1; ++rep)
        if (EN_P1 && IN(pb)) {
            PH_ARGS();
            pg8::Gemm g{(const bf16_t*)(ws + WS_XB), (const bf16_t*)(ws + WS_WIN + l * SZ_WIN), MTOK, INCOLS, DM}; pg8::StaticOrder S; S.init(MTOK, INCOLS, G_, bid_, DBG_ROT);
            pg8::Unit u0; const int pm0 = S.next(0, u0) ? u0.pm : -1;
            if (pm0 >= 0) panel_rstd_to_lds((const float*)(ws + WS_SSQ), pm0, TID_OF(wv));
            __syncthreads();
            EpiIn E{l, pm0};
            pg8::gemm_phase<EpiIn>(lds, g, S, E, wv);
        }
        GRID_BAR(pb);
        if (IN(pb + 1)) {
            for (int rep = 0; rep < REP_ATT; ++rep)
            if (EN_ATT) {
                PH_ARGS();
                const bf16_t* QH = (const bf16_t*)(ws + WS_QH); const bf16_t* KH = (const bf16_t*)(ws + WS_KH); const bf16_t* VH = (const bf16_t*)(ws + WS_VH); bf16_t* A2 = (bf16_t*)(ws + WS_A2);
                int tid = TID_OF(wv); asm volatile("" : "+v"(tid)); const int lane = tid & 63;
                const float lam_init = 0.8f - 0.6f * expf(-0.3f * (float)l);
                const float* lp = ap->lam + l * 512;
                const float s1 = wave_sum(lp[lane] * lp[128 + lane] + lp[64 + lane] * lp[192 + lane], lane), s2 = wave_sum(lp[256 + lane] * lp[384 + lane] + lp[320 + lane] * lp[448 + lane], lane);
                const float lamf = __int_as_float(__builtin_amdgcn_readfirstlane(__float_as_int(expf(s1) - expf(s2) + lam_init)));
                const float* gn = ap->subln + l * 256; const int gsc = l;
                float* scr = (float*)(lds_raw + XS_OFF);
                for (int L = bid_; L < 512; L += G_) { const int xcd = L & 7, k = L >> 3, x = k & 15, bh = (k >> 4) * 8 + xcd;
                    datt::dattn_unit<0>(QH, KH, VH, A2, bh, 31 - x, lamf, gn, gsc, (char*)lds_raw, scr, TID_OF(wv), ATT_ROT ? x : 0);
                    datt::dattn_unit<0>(QH, KH, VH, A2, bh, x, lamf, gn, gsc, (char*)lds_raw, scr, TID_OF(wv), 0);
#if ATT_PROBE
                    datt::dattn_unit<ATT_PROBE>(QH, KH, VH, (bf16_t*)(ws + WS_OH), bh, 31 - x, lamf, gn, gsc, (char*)lds_raw, scr, TID_OF(wv), ATT_ROT ? x : 0);
                    datt::dattn_unit<ATT_PROBE>(QH, KH, VH, (bf16_t*)(ws + WS_OH), bh, x, lamf, gn, gsc, (char*)lds_raw, scr, TID_OF(wv), 0);
#endif
                    }
            }
            __syncthreads();
            for (int rep = 0; rep < REP_SGU; ++rep)
            if (EN_SGU) {
                PH_ARGS();
                int tid_ = TID_OF(wv); asm volatile("" : "+v"(tid_));
                const int tid = tid_, lane = tid & 63, wid = wv;
                const float* LNST = (const float*)(ws + WS_LNST); const bf16_t* WST = (const bf16_t*)(ws + WS_WST); const bf16_t* GV = (const bf16_t*)(ws + WS_GV); const bf16_t* U = (const bf16_t*)(ws + WS_U); bf16_t* A2 = (bf16_t*)(ws + WS_A2);
                const float* ln_g = ap->sgu_ln_g + l * DM; const float* ln_b = ap->sgu_ln_b + l * DM; const float* b_sp = ap->b_spatial + l * 8 * 128;
                constexpr int WT_OFF = 0, XT_OFF = 34816, ST_OFF = 104448, RS = 272;
                LAS f32x2* ST = (LAS f32x2*)(lds + ST_OFF);
                const int r32 = lane & 31, hi = lane >> 5;
                for (int unit = bid_; unit < 1024; unit += G_) {
                    const int ch = unit >> 3, g = unit & 7, m0 = ch * 128;
                    const int cg = wid * 4 + (lane & 3), c0 = g * 256 + cg * 8;
                    u32x4 gvv[4][2]; u32x2 uuv[4][4]; u32x4 wv4[4]; f32x4 sa = {0.f, 0.f, 0.f, 0.f}, sb = sa, sc = sa, sd = sa;
                    if (tid < 128) { const f32x4* p = (const f32x4*)(LNST + (size_t)(m0 + tid) * 16); sa = p[0]; sb = p[1]; sc = p[2]; sd = p[3]; }
                    { const bf16_t* wsrc = WST + (size_t)(l * 8 + g) * 128 * 128;
#pragma unroll
                        for (int i = 0; i < 4; ++i) { const int chunk = tid + 512 * i, row = chunk >> 4, cc = chunk & 15; wv4[i] = *(const u32x4*)(wsrc + row * 128 + cc * 8); } }
#pragma unroll
                    for (int it = 0; it < 4; ++it) { const int j = 2 * (it * 16 + (lane >> 2)); gvv[it][0] = *(const u32x4*)(GV + (size_t)(m0 + j) * DM + c0); gvv[it][1] = *(const u32x4*)(GV + (size_t)(m0 + j + 1) * DM + c0); }
#pragma unroll
                    for (int ib = 0; ib < 4; ++ib)
#pragma unroll
                        for (int rg = 0; rg < 4; ++rg) uuv[ib][rg] = *(const u32x2*)(U + (size_t)(m0 + 32 * ib + r32) * DM + g * 256 + 32 * wid + 8 * rg + 4 * hi);
                    const f32x4 lg0 = *(const f32x4*)(ln_g + c0), lg1 = *(const f32x4*)(ln_g + c0 + 4), lb0 = *(const f32x4*)(ln_b + c0), lb1 = *(const f32x4*)(ln_b + c0 + 4);
                    if (tid < 128) { const f32x4 a = sa, b = sb, c = sc, d = sd;
                        const float s1 = ((a[0] + a[2]) + (b[0] + b[2])) + ((c[0] + c[2]) + (d[0] + d[2])), s2 = ((a[1] + a[3]) + (b[1] + b[3])) + ((c[1] + c[3]) + (d[1] + d[3]));
                        const float mean = s1 * (1.0f / DM), var = fmaxf(s2 * (1.0f / DM) - mean * mean, 0.f); ST[tid] = (f32x2){mean, 1.0f / sqrtf(var + EPS)}; }
#pragma unroll
                    for (int i = 0; i < 4; ++i) { const int chunk = tid + 512 * i, row = chunk >> 4, cc = chunk & 15; *(LAS u32x4*)(lds + WT_OFF + row * RS + cc * 16) = wv4[i]; }
                    __syncthreads();
                    {
#pragma unroll
                        for (int it = 0; it < 4; ++it) { const int j = 2 * (it * 16 + (lane >> 2));
                            const u32x4 v0 = gvv[it][0], v1 = gvv[it][1];
                            const f32x2 st0 = ST[j], st1 = ST[j + 1];
#pragma unroll
                            for (int q = 0; q < 4; ++q) { const float ga = q < 2 ? lg0[2 * q] : lg1[2 * q - 4], gb = q < 2 ? lg0[2 * q + 1] : lg1[2 * q - 3], ba = q < 2 ? lb0[2 * q] : lb1[2 * q - 4], bb = q < 2 ? lb0[2 * q + 1] : lb1[2 * q - 3];
                                const float a0 = (bf_lo(v0[q]) - st0.x) * st0.y * ga + ba, a1 = (bf_lo(v1[q]) - st1.x) * st1.y * ga + ba;
                                const float b0 = (bf_hi(v0[q]) - st0.x) * st0.y * gb + bb, b1 = (bf_hi(v1[q]) - st1.x) * st1.y * gb + bb;
                                *(LAS unsigned*)(lds + XT_OFF + (cg * 8 + 2 * q) * RS + j * 2) = cvt_pk_bf16(a0, a1);
                                *(LAS unsigned*)(lds + XT_OFF + (cg * 8 + 2 * q + 1) * RS + j * 2) = cvt_pk_bf16(b0, b1); } } }
                    __syncthreads();
                    f32x16 acc[4] = {};
#pragma unroll
                    for (int ks = 0; ks < 8; ++ks) { const bf16x8 a = *(const LAS bf16x8*)(lds + XT_OFF + (32 * wid + r32) * RS + (16 * ks + 8 * hi) * 2);
#pragma unroll
                        for (int ib = 0; ib < 4; ++ib) if (ks <= 2 * ib + 1) { const bf16x8 b = *(const LAS bf16x8*)(lds + WT_OFF + (32 * ib + r32) * RS + (16 * ks + 8 * hi) * 2);
                            acc[ib] = __builtin_amdgcn_mfma_f32_32x32x16_bf16(a, b, acc[ib], 0, 0, 0); } }
#pragma unroll
                    for (int ib = 0; ib < 4; ++ib) { const int i = 32 * ib + r32; const float bs = b_sp[g * 128 + i];
#pragma unroll
                        for (int rg = 0; rg < 4; ++rg) { const int cc = g * 256 + 32 * wid + 8 * rg + 4 * hi;
                            const u32x2 uu = uuv[ib][rg];
                            const f32x4 ug = gelu4((f32x4){bf_lo(uu.x), bf_hi(uu.x), bf_lo(uu.y), bf_hi(uu.y)});
                            u32x2 o; o.x = cvt_pk_bf16(ug[0] * (acc[ib][4 * rg] + bs), ug[1] * (acc[ib][4 * rg + 1] + bs)); o.y = cvt_pk_bf16(ug[2] * (acc[ib][4 * rg + 2] + bs), ug[3] * (acc[ib][4 * rg + 3] + bs));
                            *(u32x2*)(A2 + (size_t)(m0 + i) * KBR + DM + cc) = o; } }
                    __syncthreads();
                }
            }
        }
        GRID_BAR(pb + 1);
        for (int rep = 0; rep < REP_P4; ++rep)
        if (EN_P4 && IN(pb + 3)) {
            PH_ARGS();
            pg8::Gemm g{(const bf16_t*)(ws + WS_A2), (const bf16_t*)(ws + WS_WBR + l * SZ_WBR), MTOK, DM, KBR}; pg8::StaticOrder S; S.init(MTOK, DM, G_, bid_);
            EpiBranch E{};
            pg8::gemm_phase<EpiBranch>(lds, g, S, E, wv);
        }
        GRID_BAR(pb + 3);
        if (EN_P5 && IN(pb + 4)) {
            PH_ARGS();
            pg8::Gemm g{(const bf16_t*)(ws + WS_MRG), (const bf16_t*)(ws + WS_WOUT + l * SZ_WOUT), MTOK, DM, DM}; pg8::StaticOrder S; S.init(MTOK, DM, G_, bid_);
            EpiResid E{l == 0 ? 1 : 0, 0};
            pg8::gemm_phase<EpiResid>(lds, g, S, E, wv);
        }
        GRID_BAR(pb + 4);
        for (int rep = 0; rep < REP_P6; ++rep)
        if (EN_P6 && IN(pb + 5)) {
            PH_ARGS();
            pg8::Gemm g{(const bf16_t*)(ws + WS_XB), (const bf16_t*)(ws + WS_WFI + l * SZ_WFI), MTOK, 2 * FFH, DM}; pg8::StaticOrder S; S.init(MTOK, 2 * FFH, G_, bid_);
            pg8::Unit u0; const int pm0 = S.next(0, u0) ? u0.pm : -1;
            if (pm0 >= 0) panel_rstd_to_lds((const float*)(ws + WS_SSQ), pm0, TID_OF(wv));
            __syncthreads();
            EpiSwiglu E{pm0, (REP_P6_SKIPEPI && rep > 0) ? 1 : 0};
            pg8::gemm_phase<EpiSwiglu>(lds, g, S, E, wv);
        }
        GRID_BAR(pb + 5);
        if (EN_P7 && IN(pb + 6)) {
            PH_ARGS();
            pg8::Gemm g{(const bf16_t*)(ws + WS_HID), (const bf16_t*)(ws + WS_WFO + l * SZ_WFO), MTOK, DM, FFH}; pg8::StaticOrder S; S.init(MTOK, DM, G_, bid_);
            EpiResid E{0, l == DEPTH - 1 ? 1 : 0};
            pg8::gemm_phase<EpiResid>(lds, g, S, E, wv);
        }
        GRID_BAR(pb + 6);
    }
    if (DBG_CUT > 0) {
        if (IN(29)) { PH_ARGS(); float* out = ap->out; const int tid = TID_OF(wv);
            for (size_t i = (size_t)bid_ * 512 + tid; i < (size_t)MTOK * DM; i += (size_t)G_ * 512) { const size_t m = i >> 11, c = i & 2047; float v = 0.f;
                if (DBG_SRC == 1) { const bf16_t* A2 = (const bf16_t*)(ws + WS_A2); v = __uint_as_float((unsigned)A2[m * KBR + c] << 16) + __uint_as_float((unsigned)A2[m * KBR + DM + c] << 16); }
                if (DBG_SRC == 2) { const bf16_t* p = (const bf16_t*)(ws + WS_QH); v = __uint_as_float((unsigned)p[i] << 16) + __uint_as_float((unsigned)p[i + (size_t)MTOK * DM] << 16) + __uint_as_float((unsigned)p[i + 2 * (size_t)MTOK * DM] << 16); }
                if (DBG_SRC == 3) { const bf16_t* p = (const bf16_t*)(ws + WS_U); v = __uint_as_float((unsigned)p[i] << 16) + __uint_as_float((unsigned)p[i + (size_t)MTOK * DM] << 16) + __uint_as_float((unsigned)p[i + 2 * (size_t)MTOK * DM] << 16) + __uint_as_float((unsigned)p[i + 3 * (size_t)MTOK * DM] << 16) + ((const float*)(ws + WS_LNST))[i & (MTOK * 16 - 1)]; }
                if (DBG_SRC == 8) { const bf16_t* p = (const bf16_t*)(ws + WS_GA); v = __uint_as_float((unsigned)p[i] << 16) + __uint_as_float((unsigned)p[i + (size_t)MTOK * DM] << 16); }
                if (DBG_SRC == 9) { const bf16_t* p = (const bf16_t*)(ws + WS_U); v = __uint_as_float((unsigned)p[i] << 16) + __uint_as_float((unsigned)p[i + (size_t)MTOK * DM] << 16); }
                if (DBG_SRC == 4) { v = ((const float*)(ws + WS_X))[i] + ((const float*)(ws + WS_SSQ))[i & (MTOK * 8 - 1)]; }
                if (DBG_SRC == 5) { const bf16_t* p = (const bf16_t*)(ws + WS_MRG); v = __uint_as_float((unsigned)p[i] << 16); }
                if (DBG_SRC == 6) { const bf16_t* p = (const bf16_t*)(ws + WS_HID); v = __uint_as_float((unsigned)p[i] << 16) + __uint_as_float((unsigned)p[i + (size_t)MTOK * DM] << 16); }
                if (DBG_SRC == 7) { const float* p = (const float*)(ws + WS_OH); v = p[i] + p[i + (size_t)MTOK * DM]; }
                out[i] = v; } }
    } else
    if (IN(29)) {
        PH_ARGS();
        const int tid = TID_OF(wv), lane = tid & 63, wid = wv, gw = bid_ * 8 + wid, NGW = G_ * 8; (void)tid;
        const float* SSQ = (const float*)(ws + WS_SSQ); const float* X = (const float*)(ws + WS_X); const float* nf = ap->norm_final; float* out = ap->out;
        for (int m = gw; m < MTOK; m += NGW) { const float rs = row_rstd(SSQ, m);
            const f32x4* xr = (const f32x4*)(X + (size_t)m * DM) + lane; const f32x4* gr = (const f32x4*)nf + lane; f32x4* orow = (f32x4*)(out + (size_t)m * DM) + lane;
#pragma unroll
            for (int j = 0; j < 8; ++j) orow[64 * j] = xr[64 * j] * rs * gr[64 * j]; }
    }
#undef IN
#undef GRID_BAR
}

extern "C" void kernel_launch(void* const* d_in, const int* in_sizes, int n_in, void* d_out, int out_size, void* d_ws, size_t ws_size, hipStream_t stream) {
    static int grid = 0;
    if (grid == 0) {
        if (n_in != 17 || out_size != MTOK * DM || ws_size < WS_END) { fprintf(stderr, "kernel_launch: unexpected shapes (n_in %d, out %d, ws %zu < %zu); nothing launched\n", n_in, out_size, ws_size, (size_t)WS_END); grid = -1; return; }
        int dev = 0, cus = 0;
        if (hipGetDevice(&dev) != hipSuccess || hipDeviceGetAttribute(&cus, hipDeviceAttributeMultiprocessorCount, dev) != hipSuccess) { grid = -1; return; }
        if (hipFuncSetAttribute((const void*)mk_fwd, hipFuncAttributeMaxDynamicSharedMemorySize, LDS_BYTES) != hipSuccess) { fprintf(stderr, "kernel_launch: hipFuncSetAttribute failed\n"); grid = -1; return; }
        int per_cu = 0;
        if (hipOccupancyMaxActiveBlocksPerMultiprocessor(&per_cu, (const void*)mk_fwd, 512, LDS_BYTES) != hipSuccess || per_cu < 1) fprintf(stderr, "kernel_launch: occupancy query says %d\n", per_cu);
        (void)hipGetLastError();
        grid = cus;
    }
    if (grid < 0) return;
    (void)hipMemsetAsync((char*)d_ws + WS_CTL, 0, CTL_ZERO_BYTES, stream);
    Args a{};
    a.x = (const float*)d_in[0]; a.pos = (const int*)d_in[1]; a.norm_attn = (const float*)d_in[2]; a.w_in = (const float*)d_in[3]; a.gate_b = (const float*)d_in[4]; a.lam = (const float*)d_in[5];
    a.subln = (const float*)d_in[6]; a.sgu_ln_g = (const float*)d_in[7]; a.sgu_ln_b = (const float*)d_in[8]; a.w_spatial = (const float*)d_in[9]; a.b_spatial = (const float*)d_in[10];
    a.w_branch = (const float*)d_in[11]; a.w_out = (const float*)d_in[12]; a.norm_ffn = (const float*)d_in[13]; a.w_ffn_in = (const float*)d_in[14]; a.w_ffn_out = (const float*)d_in[15]; a.norm_final = (const float*)d_in[16];
    a.out = (float*)d_out; a.ws = (unsigned char*)d_ws;
#if MK_MULTI
    for (int p = 0; p < 30; ++p) { a.ph_lo = p; a.ph_hi = p + 1; hipLaunchKernelGGL(mk_fwd, dim3(grid), dim3(512), LDS_BYTES, stream, a); }
#else
    a.ph_lo = 0; a.ph_hi = 30;
    hipLaunchKernelGGL(mk_fwd, dim3(grid), dim3(512), LDS_BYTES, stream, a);
#endif
}
```
